# Optimizing an MI355X kernel written in HIP

```python
import jax, jax.numpy as jnp
from jax import lax
import numpy as np

D_MODEL = 1024
BATCH = 16
SEQ = 256
DEPTH = 2
DEC_BATCH = 4
DEC_SEQ = 1024
PAST_LEN = 256

GRID_W = 64
GROUP_W = D_MODEL // 4
CONV_W = 31
CHUNK = 128
GMLP_HEADS = 4
GMLP_HD = GROUP_W // GMLP_HEADS
POOL_WINDOWS = (2, 4, 8, 16)
POOL_GROUPS = len(POOL_WINDOWS)
POOL_GW = GROUP_W // POOL_GROUPS
RET_HEADS = 4
RET_HD = GROUP_W // RET_HEADS
RET_CHUNK = 128
ROPE_BASE = 10000.0
D_FF = -(-8 * D_MODEL // (3 * 256)) * 256
IN_COLS = 11 * GROUP_W
EPS = 1e-6

kernel_name = "hybrid_parallel_groups_diffusion_step"

F32 = jnp.float32


def _rms_norm(x, g):
    xf = x.astype(F32)
    y = xf * lax.rsqrt(jnp.mean(xf * xf, axis=-1, keepdims=True) + EPS)
    return (y * g.astype(F32)).astype(x.dtype)


def _conformer_conv(a, dw, b, ln_g, ln_b, pw):
    a1, a2 = jnp.split(a, 2, axis=-1)
    h = a1 * jax.nn.sigmoid(a2)
    h = lax.conv_general_dilated(h, dw[:, None, :].astype(h.dtype), window_strides=(1,),
                                 padding=[(CONV_W // 2, CONV_W // 2)],
                                 dimension_numbers=('NWC', 'WIO', 'NWC'),
                                 feature_group_count=GROUP_W) + b
    hf = h.astype(F32)
    mu = jnp.mean(hf, axis=-1, keepdims=True)
    var = jnp.mean(jnp.square(hf - mu), axis=-1, keepdims=True)
    hn = (hf - mu) * lax.rsqrt(var + EPS) * ln_g.astype(F32) + ln_b.astype(F32)
    return jax.nn.silu(hn).astype(a.dtype) @ pw


def _chunk_gmlp(uv, ws, b):
    u, v = jnp.split(uv, 2, axis=-1)
    B, L, _ = v.shape
    vh = v.reshape(B, L // CHUNK, CHUNK, GMLP_HEADS, GMLP_HD)
    s = jnp.einsum('hpq,bnqhd->bnphd', ws, vh) + jnp.swapaxes(b, 0, 1)[:, :, None]
    return u * s.reshape(B, L, GROUP_W)


def _multiscale_pool(p, pool_w, pool_scale):
    B, L, _ = p.shape
    pf = p.astype(F32)
    csum = jnp.concatenate([jnp.zeros((B, 1, GROUP_W), F32), jnp.cumsum(pf, axis=1)], axis=1)
    t = jnp.arange(L)
    outs = []
    for gi, w in enumerate(POOL_WINDOWS):
        lo = jnp.clip(t - w // 2, 0, L)
        hi = jnp.clip(t + w // 2, 0, L)
        sl = slice(gi * POOL_GW, (gi + 1) * POOL_GW)
        cs = csum[:, :, sl]
        mean = (cs[:, hi] - cs[:, lo]) / (hi - lo).astype(F32)[None, :, None]
        outs.append(mean - pf[:, :, sl])
    d = jnp.stack(outs, axis=2).astype(p.dtype)
    y = jnp.einsum('blgc,gcd->blgd', d, pool_w).reshape(B, L, GROUP_W)
    return y * pool_scale


def _axial_rope(x):
    L = x.shape[2]
    rows = L // GRID_W
    r = jnp.repeat(jnp.arange(rows, dtype=F32), GRID_W)
    c = (jnp.arange(rows * GRID_W) % GRID_W).astype(F32)
    nf = RET_HD // 4
    inv = ROPE_BASE ** (-jnp.arange(nf, dtype=F32) / nf)
    xf = x.astype(F32)

    def rot(xh, pos):
        ang = pos[:, None] * inv
        cos, sin = jnp.cos(ang), jnp.sin(ang)
        x1, x2 = xh[..., :nf], xh[..., nf:]
        return jnp.concatenate([x1 * cos - x2 * sin, x1 * sin + x2 * cos], axis=-1)

    half = RET_HD // 2
    return jnp.concatenate([rot(xf[..., :half], r), rot(xf[..., half:], c)], axis=-1).astype(x.dtype)


def _retention_scan(q, k, v, log_gamma, s0):
    B, H, L, d = q.shape
    n = L // RET_CHUNK

    def chunks(z):
        return jnp.moveaxis(z.reshape(B, H, n, RET_CHUNK, d), 2, 0)

    i = jnp.arange(RET_CHUNK, dtype=F32)
    diff = i[:, None] - i[None, :]
    lower = diff >= 0
    dmask = jnp.where(lower, jnp.exp(jnp.where(lower, diff, 0.0)[None] * log_gamma[:, None, None]), 0.0)
    q_dec = jnp.exp((i + 1.0)[None, :] * log_gamma[:, None])
    k_dec = jnp.exp((RET_CHUNK - 1.0 - i)[None, :] * log_gamma[:, None])
    s_dec = jnp.exp(RET_CHUNK * log_gamma)

    def step(s, qkv):
        qc, kc, vc = qkv
        att = jnp.einsum('bhid,bhjd->bhij', qc, kc) * dmask
        o = (jnp.einsum('bhij,bhje->bhie', att, vc)
             + jnp.einsum('bhid,bhde->bhie', qc, s) * q_dec[:, :, None])
        s = s * s_dec[:, None, None] + jnp.einsum('bhjd,bhje->bhde', kc * k_dec[:, :, None], vc)
        return s, o

    s_fin, o = lax.scan(step, s0, (chunks(q), chunks(k), chunks(v)))
    return jnp.moveaxis(o, 0, 2).reshape(B, H, L, d), s_fin


def _retention(r, log_gamma2, s0, rotate):
    B, L, _ = r.shape

    def heads(z):
        return jnp.swapaxes(z.reshape(B, L, RET_HEADS, RET_HD), 1, 2)

    qf, kf, qb, kb, v, g = jnp.split(r, 6, axis=-1)
    qf, kf, qb, kb, v = heads(qf), heads(kf), heads(qb), heads(kb), heads(v)
    if rotate:
        qf, kf, qb, kb = _axial_rope(qf), _axial_rope(kf), _axial_rope(qb), _axial_rope(kb)
    ks = RET_HD ** -0.5
    vf = v.astype(F32)
    o_f, s_f = _retention_scan(qf.astype(F32), kf.astype(F32) * ks, vf, log_gamma2[0], s0[:, 0])
    flip = lambda z: jnp.flip(z, axis=2)
    o_b, s_b = _retention_scan(flip(qb.astype(F32)), flip(kb.astype(F32)) * ks, flip(vf), log_gamma2[1], s0[:, 1])
    o = o_f + flip(o_b)
    mu = jnp.mean(o, axis=-1, keepdims=True)
    var = jnp.mean(jnp.square(o - mu), axis=-1, keepdims=True)
    on = ((o - mu) * lax.rsqrt(var + EPS))
    on = jnp.swapaxes(on, 1, 2).reshape(B, L, GROUP_W).astype(r.dtype)
    return jax.nn.silu(g) * on, jnp.stack([s_f, s_b], axis=1)


def _layer(x, mod, s0, rotate, g_norm1, g_norm2, w_in, w_out, conv_dw, conv_b, conv_ln_g, conv_ln_b,
           conv_pw, gmlp_ws, gmlp_b, pool_w, pool_scale, ret_decay, w_ffn_in, w_ffn_out):
    sh1, sc1, ga1, sh2, sc2, ga2 = jnp.split(mod, 6, axis=-1)
    h = _rms_norm(x, g_norm1) * (1.0 + sc1) + sh1
    proj = h @ w_in
    a, uv, p, r = jnp.split(proj, [2 * GROUP_W, 4 * GROUP_W, 5 * GROUP_W], axis=-1)
    ya = _conformer_conv(a, conv_dw, conv_b, conv_ln_g, conv_ln_b, conv_pw)
    yb = _chunk_gmlp(uv, gmlp_ws, gmlp_b)
    yc = _multiscale_pool(p, pool_w, pool_scale)
    yd, s_new = _retention(r, jax.nn.log_sigmoid(ret_decay.astype(F32)), s0, rotate)
    x = x + ga1 * (jnp.concatenate([ya, yb, yc, yd], axis=-1) @ w_out)
    h = _rms_norm(x, g_norm2) * (1.0 + sc2) + sh2
    gt, up = jnp.split(h @ w_ffn_in, 2, axis=-1)
    x = x + ga2 * ((jax.nn.silu(gt) * up) @ w_ffn_out)
    return x, s_new


def setup_inputs(seed: int = 0) -> dict:
    key = jax.random.key(seed)
    ks = jax.random.split(key, 32)
    nrm = lambda k, shape, s: jax.random.normal(k, shape, F32) * s
    gam = 1.0 - 2.0 ** jnp.linspace(-5.0, -12.0, RET_HEADS, dtype=F32)
    logit = jnp.log(gam) - jnp.log1p(-gam)
    return {
        'x_prompt': nrm(ks[0], (BATCH, SEQ, D_MODEL), 1.0),
        'x_sample': nrm(ks[1], (DEC_BATCH, DEC_SEQ, D_MODEL), 1.0),
        'state_ret': nrm(ks[2], (DEC_BATCH, DEPTH, 2, RET_HEADS, RET_HD, RET_HD), 0.25),
        'c': nrm(ks[3], (DEC_BATCH, D_MODEL), 1.0),
        'c_ctx': nrm(ks[4], (D_MODEL,), 1.0),
        'w_ada': nrm(ks[5], (DEPTH, D_MODEL, 6 * D_MODEL), 0.5 * D_MODEL ** -0.5),
        'b_ada': nrm(ks[6], (DEPTH, 6 * D_MODEL), 0.02),
        'g_norm1': 1.0 + nrm(ks[7], (DEPTH, D_MODEL), 0.02),
        'g_norm2': 1.0 + nrm(ks[8], (DEPTH, D_MODEL), 0.02),
        'w_in': nrm(ks[9], (DEPTH, D_MODEL, IN_COLS), D_MODEL ** -0.5),
        'w_out': nrm(ks[10], (DEPTH, D_MODEL, D_MODEL), D_MODEL ** -0.5),
        'conv_dw': nrm(ks[11], (DEPTH, CONV_W, GROUP_W), CONV_W ** -0.5),
        'conv_b': nrm(ks[12], (DEPTH, GROUP_W), 0.02),
        'conv_ln_g': 1.0 + nrm(ks[13], (DEPTH, GROUP_W), 0.02),
        'conv_ln_b': nrm(ks[14], (DEPTH, GROUP_W), 0.02),
        'conv_pw': nrm(ks[15], (DEPTH, GROUP_W, GROUP_W), GROUP_W ** -0.5),
        'gmlp_ws': nrm(ks[16], (DEPTH, GMLP_HEADS, CHUNK, CHUNK), CHUNK ** -0.5),
        'gmlp_b': 1.0 + nrm(ks[17], (DEPTH, GMLP_HEADS, CHUNK), 0.02),
        'pool_w': nrm(ks[18], (DEPTH, POOL_GROUPS, POOL_GW, POOL_GW), POOL_GW ** -0.5),
        'pool_scale': 1.0 + nrm(ks[19], (DEPTH, GROUP_W), 0.02),
        'ret_decay': logit[None, None, :] + nrm(ks[20], (DEPTH, 2, RET_HEADS), 0.05),
        'w_ffn_in': nrm(ks[21], (DEPTH, D_MODEL, 2 * D_FF), D_MODEL ** -0.5),
        'w_ffn_out': nrm(ks[22], (DEPTH, D_FF, D_MODEL), D_FF ** -0.5),
        'g_final': 1.0 + nrm(ks[23], (D_MODEL,), 0.02),
    }


def reference(x_prompt, x_sample, state_ret, c, c_ctx, w_ada, b_ada, g_norm1, g_norm2, w_in, w_out,
              conv_dw, conv_b, conv_ln_g, conv_ln_b, conv_pw, gmlp_ws, gmlp_b, pool_w, pool_scale,
              ret_decay, w_ffn_in, w_ffn_out, g_final):
    xc = x_prompt
    s_zero = jnp.zeros((x_prompt.shape[0], 2, RET_HEADS, RET_HD, RET_HD), F32)
    ctx_states = []
    xl = x_sample
    for l in range(DEPTH):
        mod_ctx = (jax.nn.silu(c_ctx) @ w_ada[l] + b_ada[l])[None, None, :]
        xc, s_new = _layer(xc, mod_ctx, s_zero, False, g_norm1[l], g_norm2[l], w_in[l], w_out[l],
                           conv_dw[l], conv_b[l], conv_ln_g[l], conv_ln_b[l], conv_pw[l], gmlp_ws[l],
                           gmlp_b[l], pool_w[l], pool_scale[l], ret_decay[l], w_ffn_in[l], w_ffn_out[l])
        ctx_states.append(s_new)
        mod_lat = (jax.nn.silu(c) @ w_ada[l] + b_ada[l])[:, None, :]
        xl, _ = _layer(xl, mod_lat, state_ret[:, l].astype(F32), True, g_norm1[l], g_norm2[l], w_in[l],
                       w_out[l], conv_dw[l], conv_b[l], conv_ln_g[l], conv_ln_b[l], conv_pw[l], gmlp_ws[l],
                       gmlp_b[l], pool_w[l], pool_scale[l], ret_decay[l], w_ffn_in[l], w_ffn_out[l])
    y_prompt = _rms_norm(xc, g_final)
    y_sample = _rms_norm(xl, g_final)
    new_state_ret = jnp.stack(ctx_states, axis=1).astype(x_prompt.dtype)
    return (y_prompt, y_sample, new_state_ret)
```

```cpp
#include <hip/hip_runtime.h>
#include <hip/hip_cooperative_groups.h>
#include <cstdio>
namespace cg = cooperative_groups;

typedef unsigned short bf16_t;
using bf16x8 = __attribute__((ext_vector_type(8))) short;
using f32x4 = __attribute__((ext_vector_type(4))) float;
using u32x4 = __attribute__((ext_vector_type(4))) unsigned;
using u32x2 = __attribute__((ext_vector_type(2))) unsigned;
#define DI __device__ __forceinline__
#define MFMA16(a, b, c) __builtin_amdgcn_mfma_f32_16x16x32_bf16((a), (b), (c), 0, 0, 0)

#ifndef SINGLE_LAUNCH
#define SINGLE_LAUNCH 1
#endif

constexpr int DM = 1024, NTOK = 8192, NCTX = 4096, INC = 2816, DFF = 2816;
constexpr int NPH = 15;
constexpr float EPS = 1e-6f;

struct Params {
  const float *x_prompt, *x_sample, *state_ret, *c, *c_ctx, *w_ada, *b_ada, *g_norm1, *g_norm2, *w_in, *w_out, *conv_dw,
      *conv_b, *conv_ln_g, *conv_ln_b, *conv_pw, *gmlp_ws, *gmlp_b, *pool_w, *pool_scale, *ret_decay, *w_ffn_in, *w_ffn_out,
      *g_final;
  float* out;
  bf16_t *wt_in, *wt_out, *wt_ffi, *wt_ffo, *wt_pw, *wt_pool;
  float *mod, *G1, *G2, *biasIn, *biasFf, *rope;
  bf16_t* xg;
  float *ssq, *xres;
  bf16_t* proj;
  bf16_t *mix, *act;
  float* KV;
  unsigned* bar;
};

DI int opaque_tid() { int t = threadIdx.x & 255; asm volatile("" : "+v"(t)); return t; }
DI void lds_barrier() { asm volatile("s_waitcnt lgkmcnt(0)" ::: "memory"); __builtin_amdgcn_s_barrier(); asm volatile("" ::: "memory"); }
typedef __bf16 bf16x2_t __attribute__((ext_vector_type(2)));
typedef float f32x2_t __attribute__((ext_vector_type(2)));
DI unsigned pack2(float a, float b) { f32x2_t v = {a, b}; return __builtin_bit_cast(unsigned, __builtin_convertvector(v, bf16x2_t)); }
DI unsigned short f2bf(float x) { return (unsigned short)(pack2(x, x) & 0xffffu); }
DI float bf2f(bf16_t x) { return __uint_as_float((unsigned)x << 16); }
DI f32x4 ld4bf(const bf16_t* p) {
  const u32x2 v = *(const u32x2*)p;
  return f32x4{__uint_as_float(v.x << 16), __uint_as_float(v.x & 0xffff0000u), __uint_as_float(v.y << 16), __uint_as_float(v.y & 0xffff0000u)};
}
DI void pin(f32x4& x) { asm volatile("" : "+v"(x)); }
DI float silu_f(float v) { return v * __builtin_amdgcn_rcpf(1.f + __expf(-v)); }
DI float sigmoid_f(float v) { return __builtin_amdgcn_rcpf(1.f + __expf(-v)); }

DI void tokinfo(int T, int& seqstart, int& L, int& mr) {
  if (T < NCTX) { seqstart = T & ~255; L = 256; mr = 0; }
  else { int u = T - NCTX; seqstart = NCTX + (u & ~1023); L = 1024; mr = 1 + (u >> 10); }
}
DI const float* xin_row(const Params& p, int T) {
  return T < NCTX ? p.x_prompt + (size_t)T * DM : p.x_sample + (size_t)(T - NCTX) * DM;
}
DI float loggamma(const Params& p, int l, int dir, int h) {
  float x = p.ret_decay[(l * 2 + dir) * 4 + h];
  return -log1pf(expf(-x));
}
DI float row_rstd(const float* ssq, int row) {
  const f32x4* q = (const f32x4*)(ssq + (size_t)row * 32);
  f32x4 a[8];
#pragma unroll
  for (int i = 0; i < 8; ++i) a[i] = q[i];
  float s = 0.f;
#pragma unroll
  for (int i = 0; i < 8; ++i) s += (a[i].x + a[i].y) + (a[i].z + a[i].w);
  return rsqrtf(s * (1.f / DM) + EPS);
}


#define XB_TMO      128
#define XB_XCNT(j)  (256  + 64 * (j))
#define XB_XSUB(j)  (1280 + 64 * (j))
#define XB_XGEN(j)  (2304 + 64 * (j))
#define XB_TOP      3328
#define XB_TOPGEN   3392
#define XCD_BAR_WORDS 3456
#define XB_SPIN_CAP (1u << 18)
#define LAS __attribute__((address_space(3)))
DI unsigned xb_ld(unsigned* p) { return __hip_atomic_load(p, __ATOMIC_RELAXED, __HIP_MEMORY_SCOPE_AGENT); }
DI unsigned xb_add(unsigned* p, unsigned v) { return __hip_atomic_fetch_add(p, v, __ATOMIC_RELAXED, __HIP_MEMORY_SCOPE_AGENT); }
DI unsigned xb_xcc_id() { return (unsigned)__builtin_amdgcn_s_getreg((3 << 11) | 20) & 0xFu; }
#define XB_SPIN(cond, bar) do { unsigned _sp = 0; while (cond) { __builtin_amdgcn_s_sleep(1); \
    if ((++_sp & 255u) == 0u) { if (xb_ld(&(bar)[XB_TMO])) break; if (_sp > XB_SPIN_CAP) { atomicAdd(&(bar)[XB_TMO], 1u); break; } } } } while (0)
struct XcdBarrier { unsigned* bar; unsigned x; volatile LAS unsigned* st; };
DI XcdBarrier xcd_barrier_post(unsigned* bar, volatile LAS unsigned* st) {
  XcdBarrier b; b.bar = bar; b.x = xb_xcc_id(); b.st = st;
  if (threadIdx.x == 0) (void)xb_add(&bar[XB_XCNT(b.x)], 1u);
  return b;
}
DI void xcd_barrier_complete(unsigned* bar, unsigned x, unsigned& nloc, unsigned& nx) {
  const unsigned G = gridDim.x * gridDim.y * gridDim.z;
  unsigned sum, cnt, mine, sp = 0u;
  for (;;) {
    sum = 0u; cnt = 0u; mine = 0u;
#pragma unroll
    for (unsigned j = 0; j < 16; ++j) { const unsigned c = xb_ld(&bar[XB_XCNT(j)]); sum += c; cnt += (c > 0u) ? 1u : 0u; mine = (j == x) ? c : mine; }
    if (sum == G) break;
    __builtin_amdgcn_s_sleep(1);
    if ((++sp & 255u) == 0u) { if (xb_ld(&bar[XB_TMO])) break; if (sp > XB_SPIN_CAP) { atomicAdd(&bar[XB_TMO], 1u); break; } }
  }
  nloc = mine > 0u ? mine : 1u; nx = cnt > 0u ? cnt : 1u;
}
DI void xcd_barrier(const XcdBarrier& b) {
  asm volatile("s_waitcnt vmcnt(0)" ::: "memory");
  __syncthreads();
  if (threadIdx.x == 0) {
    unsigned* bar = b.bar;
    __builtin_amdgcn_s_waitcnt(0);
    unsigned nloc = b.st[0], nx = b.st[1];
    if (nloc == 0u) { xcd_barrier_complete(bar, b.x, nloc, nx); b.st[0] = nloc; b.st[1] = nx; }
    const unsigned old = xb_add(&bar[XB_XSUB(b.x)], 1u);
    const unsigned gen = old / nloc;
    if (old + 1u == (gen + 1u) * nloc) {
      __builtin_amdgcn_fence(__ATOMIC_RELEASE, "agent");
      asm volatile("s_waitcnt vmcnt(0)" ::: "memory");
      const unsigned og = xb_add(&bar[XB_TOP], 1u);
      const unsigned tg = og / nx;
      if (og + 1u == (tg + 1u) * nx) xb_add(&bar[XB_TOPGEN], 1u);
      else XB_SPIN(xb_ld(&bar[XB_TOPGEN]) == tg, bar);
      __builtin_amdgcn_fence(__ATOMIC_ACQUIRE, "agent");
      xb_add(&bar[XB_XGEN(b.x)], 1u);
      asm volatile("s_waitcnt vmcnt(0)" ::: "memory");
    } else {
      XB_SPIN(xb_ld(&bar[XB_XGEN(b.x)]) == gen, bar);
      __builtin_amdgcn_fence(__ATOMIC_ACQUIRE, "agent");
      asm volatile("s_waitcnt vmcnt(0)" ::: "memory");
    }
  }
  __syncthreads();
}

struct TileDesc { const float* src; bf16_t* dst; int N, K, k0, n0, mode; };
DI TileDesc big_tile(const Params& p, int l, int v) {
  TileDesc d;
  if (v < 704) { d.src = p.w_in + (size_t)l * 1024 * INC; d.dst = p.wt_in + (size_t)l * INC * 1024; d.N = INC; d.K = 1024; d.k0 = (v / 44) * 64; d.n0 = (v % 44) * 64; d.mode = 0; }
  else if ((v -= 704) < 256) { d.src = p.w_out + (size_t)l * 1024 * 1024; d.dst = p.wt_out + (size_t)l * 1024 * 1024; d.N = 1024; d.K = 1024; d.k0 = (v / 16) * 64; d.n0 = (v % 16) * 64; d.mode = 0; }
  else if ((v -= 256) < 1408) { d.src = p.w_ffn_in + (size_t)l * 1024 * 5632; d.dst = p.wt_ffi + (size_t)l * 5632 * 1024; d.N = 5632; d.K = 1024; d.k0 = (v / 88) * 64; d.n0 = (v % 88) * 64; d.mode = 1; }
  else { v -= 1408; d.src = p.w_ffn_out + (size_t)l * DFF * 1024; d.dst = p.wt_ffo + (size_t)l * 1024 * DFF; d.N = 1024; d.K = DFF; d.k0 = (v / 16) * 64; d.n0 = (v % 16) * 64; d.mode = 0; }
  return d;
}
DI TileDesc small_tile(const Params& p, int l, int v) {
  TileDesc d;
  if (v < 16) { d.src = p.conv_pw + (size_t)l * 65536; d.dst = p.wt_pw + (size_t)l * 65536; d.N = 256; d.K = 256; d.k0 = (v / 4) * 64; d.n0 = (v % 4) * 64; d.mode = 0; }
  else { v -= 16; d.src = p.pool_w + (size_t)(l * 4 + v) * 4096; d.dst = p.wt_pool + (size_t)(l * 4 + v) * 4096; d.N = 64; d.K = 64; d.k0 = 0; d.n0 = 0; d.mode = 0; }
  return d;
}
DI void tile_load(const TileDesc& d, int tid, f32x4 (&r)[4]) {
#pragma unroll
  for (int i = 0; i < 4; ++i) r[i] = *(const f32x4*)(d.src + (size_t)(d.k0 + i * 16 + (tid >> 4)) * d.N + d.n0 + (tid & 15) * 4);
}
DI void tile_to_lds(int tid, const f32x4 (&r)[4], float* tile) {
#pragma unroll
  for (int i = 0; i < 4; ++i) {
    int rr = i * 16 + (tid >> 4), c4 = (tid & 15) * 4;
    tile[rr * 65 + c4 + 0] = r[i].x; tile[rr * 65 + c4 + 1] = r[i].y; tile[rr * 65 + c4 + 2] = r[i].z; tile[rr * 65 + c4 + 3] = r[i].w;
  }
}
DI void tile_store(const TileDesc& d, int tid, const float* tile) {
#pragma unroll
  for (int i = 0; i < 2; ++i) {
    int q = tid + 256 * i, nl = q >> 3, kc = q & 7;
    float f[8];
#pragma unroll
    for (int j = 0; j < 8; ++j) f[j] = tile[(kc * 8 + j) * 65 + nl];
    u32x4 o;
    o.x = pack2(f[0], f[1]); o.y = pack2(f[2], f[3]); o.z = pack2(f[4], f[5]); o.w = pack2(f[6], f[7]);
    int n = d.n0 + nl, np = n;
    if (d.mode == 1) {
      if (n < DFF) np = 256 * (n >> 7) + (n & 127);
      else { int n2 = n - DFF; np = 256 * (n2 >> 7) + 128 + (n2 & 127); }
    }
    *(u32x4*)(d.dst + (size_t)np * d.K + d.k0 + kc * 8) = o;
  }
}
template <class Decode>
DI void transpose_run(int first, int n, int stride, const Decode& dec, char* lds) {
  const int tid = opaque_tid();
  float* tile = (float*)lds;
  int t = first;
  TileDesc d, dn;
  f32x4 cur[4], nxt[4];
  if (t < n) { d = dec(t); tile_load(d, tid, cur); }
  while (t < n) {
    tile_to_lds(tid, cur, tile);
    lds_barrier();
    const int tn = t + stride;
    dn = d;
    if (tn < n) { dn = dec(tn); tile_load(dn, tid, nxt); }
    tile_store(d, tid, tile);
    lds_barrier();
    d = dn;
#pragma unroll
    for (int i = 0; i < 4; ++i) cur[i] = nxt[i];
    t = tn;
  }
}

DI void gemv5_task(const float* S, const float* W, int N, int n0, const float* bias, float* out, float* red) {
  const int tid = opaque_tid(), c4 = (tid & 7) * 4, ks = tid >> 3;
  f32x4 a[5];
#pragma unroll
  for (int r = 0; r < 5; ++r) a[r] = f32x4{0.f, 0.f, 0.f, 0.f};
  const float* wp = W + (size_t)(ks * 32) * N + n0 + c4;
  const float* sp = S + ks * 32;
  {
    constexpr int kb = 0;
    f32x4 w[32];
#pragma unroll
    for (int k = 0; k < 32; ++k) w[k] = *(const f32x4*)(wp + (size_t)(kb + k) * N);
#pragma unroll
    for (int k = 0; k < 32; ++k)
#pragma unroll
      for (int r = 0; r < 5; ++r) a[r] += w[k] * sp[r * 1024 + kb + k];
  }
#pragma unroll
  for (int r = 0; r < 5; ++r) *(f32x4*)(red + (ks * 5 + r) * 32 + c4) = a[r];
  lds_barrier();
  if (tid < 160) {
    int r = tid >> 5, cn = tid & 31;
    float s = bias ? bias[n0 + cn] : 0.f;
#pragma unroll 8
    for (int q = 0; q < 32; ++q) s += red[(q * 5 + r) * 32 + cn];
    out[(size_t)r * N + n0 + cn] = s;
  }
  lds_barrier();
}

DI void bias_task(const Params& p, int l, int which  , int blk) {
  const int tid = opaque_tid(), wid = tid >> 6, lane = tid & 63;
  const float* sb = p.mod + (size_t)l * 5 * 6144 + (which ? 3072 : 0) + lane * 16;
  f32x4 s[5][4];
#pragma unroll
  for (int r = 0; r < 5; ++r)
#pragma unroll
    for (int i = 0; i < 4; ++i) s[r][i] = *(const f32x4*)(sb + (size_t)r * 6144 + 4 * i);
  const bf16_t* wt = which ? p.wt_ffi + (size_t)l * 5632 * 1024 : p.wt_in + (size_t)l * INC * 1024;
  u32x4 wraw[8][2];
#pragma unroll
  for (int c = 0; c < 8; ++c) {
    const bf16_t* wp = wt + (size_t)(blk * 32 + wid * 8 + c) * 1024 + lane * 16;
    wraw[c][0] = *(const u32x4*)wp; wraw[c][1] = *(const u32x4*)(wp + 8);
  }
  float acc[8][5];
#pragma unroll
  for (int c = 0; c < 8; ++c) {
    const u32x4 w0 = wraw[c][0], w1 = wraw[c][1];
    f32x4 wf[4];
    wf[0] = f32x4{__uint_as_float(w0.x << 16), __uint_as_float(w0.x & 0xffff0000u), __uint_as_float(w0.y << 16), __uint_as_float(w0.y & 0xffff0000u)};
    wf[1] = f32x4{__uint_as_float(w0.z << 16), __uint_as_float(w0.z & 0xffff0000u), __uint_as_float(w0.w << 16), __uint_as_float(w0.w & 0xffff0000u)};
    wf[2] = f32x4{__uint_as_float(w1.x << 16), __uint_as_float(w1.x & 0xffff0000u), __uint_as_float(w1.y << 16), __uint_as_float(w1.y & 0xffff0000u)};
    wf[3] = f32x4{__uint_as_float(w1.z << 16), __uint_as_float(w1.z & 0xffff0000u), __uint_as_float(w1.w << 16), __uint_as_float(w1.w & 0xffff0000u)};
#pragma unroll
    for (int r = 0; r < 5; ++r) {
      f32x4 t = s[r][0] * wf[0] + s[r][1] * wf[1] + s[r][2] * wf[2] + s[r][3] * wf[3];
      acc[c][r] = (t.x + t.y) + (t.z + t.w);
    }
  }
#pragma unroll
  for (int of = 32; of >= 1; of >>= 1) {
    float t[8][5];
#pragma unroll
    for (int c = 0; c < 8; ++c)
#pragma unroll
      for (int r = 0; r < 5; ++r) t[c][r] = __shfl_xor(acc[c][r], of);
#pragma unroll
    for (int c = 0; c < 8; ++c)
#pragma unroll
      for (int r = 0; r < 5; ++r) acc[c][r] += t[c][r];
  }
  if (lane == 0) {
#pragma unroll
    for (int c = 0; c < 8; ++c) {
      const int np = blk * 32 + wid * 8 + c;
      if (which == 0) {
#pragma unroll
        for (int r = 0; r < 5; ++r) p.biasIn[(size_t)(l * 5 + r) * INC + np] = acc[c][r];
      } else {
        const int q = np >> 8, rr = np & 255;
        const int col = rr < 128 ? 128 * q + rr : DFF + 128 * q + rr - 128;
#pragma unroll
        for (int r = 0; r < 5; ++r) p.biasFf[(size_t)(l * 5 + r) * 5632 + col] = acc[c][r];
      }
    }
  }
}
DI void bias_tasks(const Params& p, int l, int first, int stride) {
  for (int t = first; t < 264; t += stride) {
    if (t < 88) bias_task(p, l, 0, t);
    else bias_task(p, l, 1, t - 88);
  }
}

struct DecPrep0 { const Params* p; DI TileDesc operator()(int t) const { return t < 704 ? big_tile(*p, 0, t) : (t < 724 ? small_tile(*p, 0, t - 704) : small_tile(*p, 1, t - 724)); } };
struct DecRest { const Params* p; int l; DI TileDesc operator()(int t) const { return big_tile(*p, l, 704 + t); } };
struct DecIn1 { const Params* p; DI TileDesc operator()(int t) const { return big_tile(*p, 1, t); } };

DI void phase_prep0(const Params& p, char* lds, int vbi, int nvb) {
  const int tid = opaque_tid();
  float* S = (float*)lds;
  float* red = (float*)(lds + 20480);
  constexpr int NGEMV = 2 * 192;
  if (vbi < NGEMV) {
    float cv[20];
#pragma unroll
    for (int j = 0; j < 20; ++j) {
      const int i = tid + 256 * j, r = i >> 10, k = i & 1023;
      cv[j] = r == 0 ? p.c_ctx[k] : p.c[(r - 1) * 1024 + k];
    }
#pragma unroll
    for (int j = 0; j < 20; ++j) S[tid + 256 * j] = silu_f(cv[j]);
    lds_barrier();
    for (int t = vbi; t < NGEMV; t += nvb) {
      int l = t / 192, nb = t % 192;
      gemv5_task(S, p.w_ada + (size_t)l * 1024 * 6144, 6144, nb * 32, p.b_ada + l * 6144, p.mod + (size_t)l * 5 * 6144, red);
    }
  } else if (vbi == NGEMV) {
    for (int i = tid; i < 1024; i += 256) {
      int pos = i >> 4, f = i & 15;
      float inv = exp2f(-(float)f * (1.f / 16.f) * 13.287712379549449f);
      float ang = (float)pos * inv;
      p.rope[2 * i] = cosf(ang);
      p.rope[2 * i + 1] = sinf(ang);
    }
  }
  DecPrep0 dec{&p};
  transpose_run((vbi + nvb - (NGEMV & ~1)) % nvb, 744, nvb, dec, lds);
}

DI void phase_prep1(const Params& p, char* lds, int vbi, int nvb) {
  const int tid = opaque_tid(), wid = tid >> 6, lane = tid & 63;
  constexpr int NB = 88;
  constexpr int NG = 80;
  constexpr int NXG = NTOK / 16;
  const int ntask = NB + NG + NXG;
  for (int t = vbi; t < ntask; t += nvb) {
    if (t < NB) {
      bias_task(p, 0, 0, t);
    } else if (t < NB + NG) {
      int i = (t - NB) * 256 + tid;
      int which = i / 10240, rem = i % 10240, l = rem / 5120, r = (rem % 5120) >> 10, k = rem & 1023;
      if (which == 0) p.G1[(l * 5 + r) * 1024 + k] = p.g_norm1[l * 1024 + k] * (1.f + p.mod[(size_t)(l * 5 + r) * 6144 + 1024 + k]);
      else p.G2[(l * 5 + r) * 1024 + k] = p.g_norm2[l * 1024 + k] * (1.f + p.mod[(size_t)(l * 5 + r) * 6144 + 4096 + k]);
    } else {
      int rb = (t - NB - NG) * 16 + wid * 4;
      for (int rr = 0; rr < 4; ++rr) {
        int T = rb + rr, ss, L, mr;
        tokinfo(T, ss, L, mr);
        const float* xr = xin_row(p, T);
        const float* mrow = p.mod + (size_t)mr * 6144 + 1024;
        float sq = 0.f;
        f32x4 xv[4], gv[4], scv[4];
#pragma unroll
        for (int i = 0; i < 4; ++i) {
          int k = i * 256 + lane * 4;
          xv[i] = *(const f32x4*)(xr + k); gv[i] = *(const f32x4*)(p.g_norm1 + k); scv[i] = *(const f32x4*)(mrow + k);
        }

#pragma unroll
        for (int i = 0; i < 4; ++i) {
          int k = i * 256 + lane * 4;
          f32x4 v = xv[i], g = gv[i], sc = scv[i];
          sq += v.x * v.x + v.y * v.y + v.z * v.z + v.w * v.w;
          u32x2 o;
          o.x = pack2(v.x * g.x * (1.f + sc.x), v.y * g.y * (1.f + sc.y));
          o.y = pack2(v.z * g.z * (1.f + sc.z), v.w * g.w * (1.f + sc.w));
          *(u32x2*)(p.xg + (size_t)T * DM + k) = o;
        }
#pragma unroll
        for (int o = 32; o >= 1; o >>= 1) sq += __shfl_xor(sq, o);
        if (lane < 32) p.ssq[(size_t)T * 32 + lane] = lane == 0 ? sq : 0.f;
      }
    }
  }
}

namespace pg8 {
constexpr int BM = 256, BK = 64, HALF = 128, HTB = HALF * BK * 2, STAGE_BYTES = 8 * HTB, NXCD = 8, WGM = 8;
DI int lds_byte(int r, int c) { const int st = (r >> 4) * 2 + (c >> 5), rr = r & 15, cc = c & 31, ob = rr * 64 + cc * 2; return st * 1024 + (ob ^ (((ob >> 9) & 1) << 5)); }
DI int perm32(int rho) { const int n = rho >> 4, i = rho & 15; return 8 * (i >> 2) + 4 * n + (i & 3); }
DI void stage_rc(int b, int& R, int& C) { const int st = b / 1024, sb = b % 1024, swz = sb ^ (((sb >> 9) & 1) << 5); R = (st >> 1) * 16 + swz / 64; C = (st & 1) * 32 + (swz % 64) / 2; }
struct Unit { int pm, pn, idx; };
struct Gemm { const bf16_t* A; const bf16_t* Bt; int M, N, K; };
struct StaticOrder {
  int nM, nN, nwg, G, c, wgm;
  DI void init(int M, int N, int tn, int G_, int c_, int wgm_ = WGM) { nM = M / BM; nN = N / tn; nwg = nM * nN; G = G_; c = c_; wgm = wgm_; }
  DI bool next(int i, Unit& u) const {
    const long L = (long)i * G + c; if (L >= nwg) return false;
    int wgid = (int)L; { const int q = nwg / NXCD, r = nwg % NXCD, xcd = wgid % NXCD, off = wgid / NXCD; wgid = (xcd < r ? xcd * (q + 1) : r * (q + 1) + (xcd - r) * q) + off; }
    const int nig = wgm * nN, gid = wgid / nig, fm = gid * wgm, gsz = (nM - fm) < wgm ? (nM - fm) : wgm;
    u.pm = fm + ((wgid % nig) % gsz); u.pn = (wgid % nig) / gsz; return true;
  }
};
DI unsigned cvt_pk_bf16(float lo, float hi) { unsigned r; asm volatile("v_cvt_pk_bf16_f32 %0, %1, %2" : "=v"(r) : "v"(lo), "v"(hi)); return r; }

template <int NH, class Epi>
DI void gemm_phase(LAS unsigned char* lds, const Gemm g, const StaticOrder& S, const Epi& E) {
  int tid = threadIdx.x; asm volatile("" : "+v"(tid));
  const int wid = __builtin_amdgcn_readfirstlane(tid >> 6), lane = tid & 63, wr = wid >> 2, wc = wid & 3, fr = lane & 15, fq = lane >> 4;
  const int K = g.K, nt = K / BK;
  unsigned voffA[2], voffB[2];
#pragma unroll
  for (int i = 0; i < 2; ++i) { int R, C; stage_rc(tid * 16 + i * 8192, R, C); voffA[i] = (unsigned)(R * K + C) * 2u; voffB[i] = (unsigned)(((R & ~31) + perm32(R & 31)) * K + C) * 2u; }
  const size_t kstep = (size_t)(BK * 2);
  const size_t hstep = (size_t)HALF * K * 2;
  const size_t tstep = 2 * hstep;
  const unsigned ldsw = (unsigned)wid * 1024u;
  const int aoff = lds_byte(wr * 64 + fr, fq * 8), boff = lds_byte(wc * 32 + fr, fq * 8);
  const unsigned ldsb = (unsigned)(size_t)lds;
#define PG8_SA(b, h) (((b) * 2 + (h)) * HTB)
#define PG8_SB(b, h) ((4 + (b) * 2 + (h)) * HTB)
#define PG8_STAGE(bufoff, gbase, voff) do { _Pragma("unroll") for (int _i = 0; _i < 2; ++_i) \
    __builtin_amdgcn_global_load_lds((const unsigned*)((const char*)(gbase) + (voff)[_i]), (LAS unsigned*)(lds + (bufoff) + ldsw + _i * 8192), 16, 0, 0); } while (0)
#define PG8_DSR(dst, addr, off) asm volatile("ds_read_b128 %0, %1 offset:" #off : "=v"(dst) : "v"(addr))
#define PG8_LDA(dst, b, h) do { const unsigned _a = ldsb + PG8_SA(b, h) + aoff; PG8_DSR(dst[0][0], _a, 0); PG8_DSR(dst[0][1], _a, 1024); PG8_DSR(dst[1][0], _a, 2048); PG8_DSR(dst[1][1], _a, 3072); \
    PG8_DSR(dst[2][0], _a, 4096); PG8_DSR(dst[2][1], _a, 5120); PG8_DSR(dst[3][0], _a, 6144); PG8_DSR(dst[3][1], _a, 7168); } while (0)
#define PG8_LDB(dst, b, h) do { const unsigned _a = ldsb + PG8_SB(b, h) + boff; PG8_DSR(dst[0][0], _a, 0); PG8_DSR(dst[0][1], _a, 1024); PG8_DSR(dst[1][0], _a, 2048); PG8_DSR(dst[1][1], _a, 3072); } while (0)
#define PG8_PIN_A(A) asm volatile("s_waitcnt lgkmcnt(0)" : "+v"(A[0][0]), "+v"(A[0][1]), "+v"(A[1][0]), "+v"(A[1][1]), "+v"(A[2][0]), "+v"(A[2][1]), "+v"(A[3][0]), "+v"(A[3][1]) :: "memory")
#define PG8_PIN_B(B) asm volatile("s_waitcnt lgkmcnt(0)" : "+v"(B[0][0]), "+v"(B[0][1]), "+v"(B[1][0]), "+v"(B[1][1]) :: "memory")
#define PG8_MMA(ai, bj, At, Bt) do { __builtin_amdgcn_s_setprio(1); _Pragma("unroll") for (int m = 0; m < 4; ++m) _Pragma("unroll") for (int n = 0; n < 2; ++n) _Pragma("unroll") for (int k = 0; k < 2; ++k) \
    acc[ai][bj][m][n] = __builtin_amdgcn_mfma_f32_16x16x32_bf16(Bt[n][k], At[m][k], acc[ai][bj][m][n], 0, 0, 0); __builtin_amdgcn_s_setprio(0); } while (0)
#define PG8_WAIT_V(n) asm volatile("s_waitcnt vmcnt(" #n ")" ::: "memory")
#define PG8_WAIT_L(n) asm volatile("s_waitcnt lgkmcnt(" #n ")" ::: "memory")
#define PG8_BAR __builtin_amdgcn_s_barrier()
#define PG8_SCHED __builtin_amdgcn_sched_barrier(0)
  Unit cur, nxt; int ui = 0;
  if (!S.next(0, cur)) return;
  cur.idx = 0;
  f32x4 acc[2][2][4][2];
#pragma unroll
  for (int a = 0; a < 2; ++a)
#pragma unroll
    for (int b = 0; b < 2; ++b)
#pragma unroll
      for (int m = 0; m < 4; ++m)
#pragma unroll
        for (int n = 0; n < 2; ++n) acc[a][b][m][n] = (f32x4){0.f, 0.f, 0.f, 0.f};
  bf16x8 At[4][2], B0[2][2], B1[2][2];
  const size_t bstep = NH * hstep;
  const char* cA = (const char*)g.A + (size_t)cur.pm * tstep; const char* cB = (const char*)g.Bt + (size_t)cur.pn * bstep;
  PG8_STAGE(PG8_SB(0, 0), cB, voffB); PG8_STAGE(PG8_SA(0, 0), cA, voffA); PG8_STAGE(PG8_SB(0, 1), cB + hstep, voffB); PG8_STAGE(PG8_SA(0, 1), cA + hstep, voffA);
  if (wr == 1) PG8_BAR;
  PG8_WAIT_V(4); PG8_BAR;
  PG8_STAGE(PG8_SB(1, 0), cB + kstep, voffB); PG8_STAGE(PG8_SA(1, 0), cA + kstep, voffA); PG8_STAGE(PG8_SB(1, 1), cB + hstep + kstep, voffB);
  PG8_WAIT_V(6); PG8_BAR;
  for (;;) {
    const bool has_next = S.next(ui + 1, nxt);
    nxt.idx = ui + 1;
    const char* nA = has_next ? (const char*)g.A + (size_t)nxt.pm * tstep : cA; const char* nB = has_next ? (const char*)g.Bt + (size_t)nxt.pn * bstep : cB;
    for (int t = 0; t < nt; t += 2) {
      const bool last = (t == nt - 2);
      const char* a1 = cA + (size_t)(t + 1) * kstep;
      const char* a2 = last ? nA : cA + (size_t)(t + 2) * kstep; const char* b2 = last ? nB : cB + (size_t)(t + 2) * kstep;
      const char* a3 = a2 + kstep; const char* b3 = b2 + kstep;
      PG8_LDB(B0, 0, 0); PG8_SCHED; PG8_LDA(At, 0, 0); PG8_STAGE(PG8_SA(1, 1), a1 + hstep, voffA);
      PG8_WAIT_L(8); PG8_BAR; PG8_PIN_A(At); PG8_PIN_B(B0); PG8_MMA(0, 0, At, B0); PG8_BAR; PG8_SCHED;
      PG8_LDB(B1, 0, 1); PG8_STAGE(PG8_SB(0, 0), b2, voffB);
      PG8_BAR; PG8_PIN_B(B1); PG8_MMA(0, 1, At, B1); PG8_BAR;
      PG8_LDA(At, 0, 1); PG8_STAGE(PG8_SA(0, 0), a2, voffA);
      PG8_BAR; PG8_PIN_A(At); PG8_MMA(1, 0, At, B0); PG8_BAR; PG8_SCHED;
      PG8_STAGE(PG8_SB(0, 1), b2 + hstep, voffB);
      PG8_WAIT_V(6); PG8_BAR; PG8_MMA(1, 1, At, B1); PG8_BAR;
      PG8_LDB(B0, 1, 0); PG8_SCHED; PG8_LDA(At, 1, 0); PG8_STAGE(PG8_SA(0, 1), a2 + hstep, voffA);
      PG8_WAIT_L(8); PG8_BAR; PG8_PIN_A(At); PG8_PIN_B(B0); PG8_MMA(0, 0, At, B0); PG8_BAR; PG8_SCHED;
      PG8_LDB(B1, 1, 1); PG8_STAGE(PG8_SB(1, 0), b3, voffB);
      PG8_BAR; PG8_PIN_B(B1); PG8_MMA(0, 1, At, B1); PG8_BAR;
      PG8_LDA(At, 1, 1); PG8_STAGE(PG8_SA(1, 0), a3, voffA);
      PG8_BAR; PG8_PIN_A(At); PG8_MMA(1, 0, At, B0); PG8_BAR; PG8_SCHED;
      PG8_STAGE(PG8_SB(1, 1), b3 + hstep, voffB);
      PG8_WAIT_V(6); PG8_BAR; PG8_MMA(1, 1, At, B1); PG8_BAR;
    }
    E(acc, cur, wr, wc, fr, fq);
    if (!has_next) break;
#pragma unroll
    for (int a = 0; a < 2; ++a)
#pragma unroll
      for (int b = 0; b < 2; ++b)
#pragma unroll
        for (int m = 0; m < 4; ++m)
#pragma unroll
          for (int n = 0; n < 2; ++n) acc[a][b][m][n] = (f32x4){0.f, 0.f, 0.f, 0.f};
    cur = nxt; cA = nA; cB = nB; ++ui;
  }
  PG8_WAIT_V(0);
  if (wr == 0) PG8_BAR;
  PG8_BAR;
#undef PG8_SA
#undef PG8_SB
#undef PG8_STAGE
#undef PG8_LDA
#undef PG8_LDB
#undef PG8_PIN_A
#undef PG8_PIN_B
#undef PG8_MMA
#undef PG8_WAIT_V
#undef PG8_WAIT_L
#undef PG8_BAR
#undef PG8_SCHED
}

template <class Pre, class Epi>
DI void gemm_phase_n128(LAS unsigned char* lds, const Gemm g, const StaticOrder& S, const Epi& E) {
  int tid = threadIdx.x; asm volatile("" : "+v"(tid));
  const int wid = __builtin_amdgcn_readfirstlane(tid >> 6), lane = tid & 63, wr = wid >> 2, wc = wid & 3, fr = lane & 15, fq = lane >> 4;
  const int K = g.K, nt = K / BK;
  unsigned voff[2], voffB[2];
#pragma unroll
  for (int i = 0; i < 2; ++i) { int R, C; stage_rc(tid * 16 + i * 8192, R, C); voff[i] = (unsigned)(R * K + C) * 2u; voffB[i] = (unsigned)(((R & ~31) + perm32(R & 31)) * K + C) * 2u; }
  const size_t kstep = (size_t)(BK * 2);
  const size_t hstep = (size_t)HALF * K * 2;
  const unsigned ldsw = (unsigned)wid * 1024u;
  const int aoff = lds_byte(wr * 64 + fr, fq * 8), boff = lds_byte(wc * 32 + fr, fq * 8);
  constexpr int BUF = 3 * HTB;
  const unsigned ldsb = (unsigned)(size_t)lds;
#define N1_STG(bufoff, gbase, vo) do { _Pragma("unroll") for (int _i = 0; _i < 2; ++_i) \
    __builtin_amdgcn_global_load_lds((const unsigned*)((const char*)(gbase) + (vo)[_i]), (LAS unsigned*)(lds + (bufoff) + ldsw + _i * 8192), 16, 0, 0); } while (0)
#define N1_STAGE3(q, kt) do { const size_t _ko = (size_t)(kt) * kstep; N1_STG((q) * BUF, cB + _ko, voffB); N1_STG((q) * BUF + HTB, cA + _ko, voff); N1_STG((q) * BUF + 2 * HTB, cA + hstep + _ko, voff); } while (0)
#define N1_LDA(dst, q, h) do { const unsigned _a = ldsb + (q) * BUF + (1 + (h)) * HTB + aoff; PG8_DSR(dst[0][0], _a, 0); PG8_DSR(dst[0][1], _a, 1024); PG8_DSR(dst[1][0], _a, 2048); PG8_DSR(dst[1][1], _a, 3072); \
    PG8_DSR(dst[2][0], _a, 4096); PG8_DSR(dst[2][1], _a, 5120); PG8_DSR(dst[3][0], _a, 6144); PG8_DSR(dst[3][1], _a, 7168); } while (0)
#define N1_LDB(dst, q) do { const unsigned _a = ldsb + (q) * BUF + boff; PG8_DSR(dst[0][0], _a, 0); PG8_DSR(dst[0][1], _a, 1024); PG8_DSR(dst[1][0], _a, 2048); PG8_DSR(dst[1][1], _a, 3072); } while (0)
#define N1_LDAH(dst, q, h, m0) do { const unsigned _a = ldsb + (q) * BUF + (1 + (h)) * HTB + aoff + (m0) * 2048; PG8_DSR(dst[m0][0], _a, 0); PG8_DSR(dst[m0][1], _a, 1024); PG8_DSR(dst[m0 + 1][0], _a, 2048); PG8_DSR(dst[m0 + 1][1], _a, 3072); } while (0)
#define N1_PIN(Bf) asm volatile("s_waitcnt lgkmcnt(0)" : "+v"(A0[0][0]), "+v"(A0[0][1]), "+v"(A0[1][0]), "+v"(A0[1][1]), "+v"(A0[2][0]), "+v"(A0[2][1]), "+v"(A0[3][0]), "+v"(A0[3][1]), \
    "+v"(A1[0][0]), "+v"(A1[0][1]), "+v"(A1[1][0]), "+v"(A1[1][1]), "+v"(A1[2][0]), "+v"(A1[2][1]), "+v"(A1[3][0]), "+v"(A1[3][1]), "+v"(Bf[0][0]), "+v"(Bf[0][1]), "+v"(Bf[1][0]), "+v"(Bf[1][1]) :: "memory")
#define N1_MMAQ(ai, At, m0, Bf) do { __builtin_amdgcn_s_setprio(1); _Pragma("unroll") for (int m = m0; m < m0 + 2; ++m) _Pragma("unroll") for (int n = 0; n < 2; ++n) _Pragma("unroll") for (int k = 0; k < 2; ++k) \
    acc[ai][0][m][n] = __builtin_amdgcn_mfma_f32_16x16x32_bf16(Bf[n][k], At[m][k], acc[ai][0][m][n], 0, 0, 0); __builtin_amdgcn_s_setprio(0); } while (0)
  Unit cur;
  for (int ui = 0; S.next(ui, cur); ++ui) {
    cur.idx = ui;
    f32x4 acc[2][2][4][2];
#pragma unroll
    for (int a = 0; a < 2; ++a)
#pragma unroll
      for (int m = 0; m < 4; ++m)
#pragma unroll
        for (int n = 0; n < 2; ++n) acc[a][0][m][n] = (f32x4){0.f, 0.f, 0.f, 0.f};
    Pre P;
    E.pre(cur, wr, wc, fr, fq, P);
    const char* cA = (const char*)g.A + (size_t)cur.pm * 2 * hstep; const char* cB = (const char*)g.Bt + (size_t)cur.pn * hstep;
    N1_STAGE3(0, 0); N1_STAGE3(1, 1); N1_STAGE3(2, 2 < nt ? 2 : 0);
    asm volatile("s_waitcnt vmcnt(12)" ::: "memory");
    __builtin_amdgcn_s_barrier(); asm volatile("" ::: "memory");
    bf16x8 A0[4][2], A1[4][2], BfA[2][2], BfB[2][2];
    N1_LDB(BfA, 0); N1_LDA(A0, 0, 0); N1_LDA(A1, 0, 1);
    int cb = 0, rb = 1;
#define N1_SCHED __builtin_amdgcn_sched_barrier(0)
#define N1_ITER(Bc, Bn) do { \
      asm volatile("s_waitcnt vmcnt(6)" ::: "memory"); \
      N1_PIN(Bc); \
      __builtin_amdgcn_s_barrier(); asm volatile("" ::: "memory"); \
      const int ts = (t + 3 < nt) ? t + 3 : 0; \
      const size_t ko = (size_t)ts * kstep; \
      N1_LDB(Bn, rb); N1_SCHED; \
      N1_MMAQ(0, A0, 0, Bc); N1_SCHED; N1_STG(cb * BUF, cB + ko, voffB); N1_LDAH(A0, rb, 0, 0); N1_SCHED; \
      N1_MMAQ(0, A0, 2, Bc); N1_SCHED; N1_STG(cb * BUF + HTB, cA + ko, voff); N1_LDAH(A0, rb, 0, 2); N1_SCHED; \
      N1_MMAQ(1, A1, 0, Bc); N1_SCHED; N1_STG(cb * BUF + 2 * HTB, cA + hstep + ko, voff); N1_LDAH(A1, rb, 1, 0); N1_SCHED; \
      N1_MMAQ(1, A1, 2, Bc); N1_SCHED; \
      N1_LDAH(A1, rb, 1, 2); \
      cb = rb; rb = rb == 2 ? 0 : rb + 1; ++t; } while (0)
    for (int t = 0; t < nt;) {
      N1_ITER(BfA, BfB);
      N1_ITER(BfB, BfA);
    }
#undef N1_ITER
#undef N1_SCHED
    asm volatile("s_waitcnt vmcnt(0) lgkmcnt(0)" ::: "memory");
    __builtin_amdgcn_s_barrier(); asm volatile("" ::: "memory");
    E(acc, cur, wr, wc, fr, fq, P);
  }
#undef N1_STG
#undef N1_STAGE3
#undef N1_LDA
#undef N1_LDB
#undef N1_PIN
#undef N1_LDAH
#undef N1_MMAQ
#undef PG8_DSR
}
}

DI void rows_rstd(const float* ssq, int row0, int fq, float (&rs)[2][4]) {
  f32x4 pv[2][4][2];
#pragma unroll
  for (int ai = 0; ai < 2; ++ai)
#pragma unroll
    for (int m = 0; m < 4; ++m) {
      const f32x4* q = (const f32x4*)(ssq + (size_t)(row0 + ai * 128 + m * 16) * 32 + 8 * fq);
      pv[ai][m][0] = q[0]; pv[ai][m][1] = q[1];
    }
#pragma unroll
  for (int ai = 0; ai < 2; ++ai)
#pragma unroll
    for (int m = 0; m < 4; ++m) {
      float s = ((pv[ai][m][0].x + pv[ai][m][0].y) + (pv[ai][m][0].z + pv[ai][m][0].w)) + ((pv[ai][m][1].x + pv[ai][m][1].y) + (pv[ai][m][1].z + pv[ai][m][1].w));
      s += __shfl_xor(s, 16); s += __shfl_xor(s, 32);
      rs[ai][m] = rsqrtf(s * (1.f / DM) + EPS);
    }
}
constexpr int EPI_MAXU = 7;
#define EPI_DSR32(dst, addr, off) asm volatile("ds_read_b32 %0, %1 offset:" #off : "=v"(dst) : "v"(addr))
#define EPI_DSR128(dst, addr, off) asm volatile("ds_read_b128 %0, %1 offset:" #off : "=v"(dst) : "v"(addr))
DI void epi_read(unsigned rs_addr, unsigned b_addr, float (&rs)[2][4], f32x4 (&bv)[4]) {
  EPI_DSR32(rs[0][0], rs_addr, 0); EPI_DSR32(rs[0][1], rs_addr, 64); EPI_DSR32(rs[0][2], rs_addr, 128); EPI_DSR32(rs[0][3], rs_addr, 192);
  EPI_DSR32(rs[1][0], rs_addr, 512); EPI_DSR32(rs[1][1], rs_addr, 576); EPI_DSR32(rs[1][2], rs_addr, 640); EPI_DSR32(rs[1][3], rs_addr, 704);
  EPI_DSR128(bv[0], b_addr, 0); EPI_DSR128(bv[1], b_addr, 16); EPI_DSR128(bv[2], b_addr, 512); EPI_DSR128(bv[3], b_addr, 528);
  asm volatile("s_waitcnt lgkmcnt(0)" : "+v"(rs[0][0]), "+v"(rs[0][1]), "+v"(rs[0][2]), "+v"(rs[0][3]), "+v"(rs[1][0]), "+v"(rs[1][1]), "+v"(rs[1][2]), "+v"(rs[1][3]),
               "+v"(bv[0]), "+v"(bv[1]), "+v"(bv[2]), "+v"(bv[3]) :: "memory");
}
DI void epi_tables(char* tab, const pg8::StaticOrder& S, const float* ssq, const float* bias, bool ffi) {
  float* t = (float*)tab;
  int tid = threadIdx.x; asm volatile("" : "+v"(tid));
  for (int i = 0; i < EPI_MAXU; ++i) {
    pg8::Unit u;
    if (!S.next(i, u)) break;
    if (tid < 256) t[i * 256 + tid] = row_rstd(ssq, u.pm * 256 + tid);
    else {
      const int c = tid - 256;
      int ss, L, mr;
      tokinfo(u.pm * 256, ss, L, mr);
      t[EPI_MAXU * 256 + i * 256 + c] = ffi ? bias[(size_t)mr * 5632 + (c < 128 ? 128 * u.pn + c : DFF + 128 * u.pn + c - 128)] : bias[(size_t)mr * INC + u.pn * 256 + c];
    }
  }
  __syncthreads();
}
struct EpiIn {
  bf16_t* proj; unsigned tab;
  DI void operator()(const f32x4 (&acc)[2][2][4][2], const pg8::Unit& u, int wr, int wc, int fr, int fq) const {
    const int row0 = u.pm * 256 + wr * 64 + fr, col0 = u.pn * 256 + wc * 32 + 8 * fq;
    const int ui = u.idx < EPI_MAXU ? u.idx : EPI_MAXU - 1;
    float rs[2][4];
    f32x4 bv[4];
    epi_read(tab + (ui * 256 + wr * 64 + fr) * 4, tab + (EPI_MAXU * 256 + ui * 256 + wc * 32 + 8 * fq) * 4, rs, bv);
#pragma unroll
    for (int ai = 0; ai < 2; ++ai)
#pragma unroll
      for (int m = 0; m < 4; ++m) {
        const int row = row0 + ai * 128 + m * 16;
        bf16_t* rowp = proj + (size_t)row * INC + col0;
#pragma unroll
        for (int bj = 0; bj < 2; ++bj) {
          const f32x4 v0 = acc[ai][bj][m][0] * rs[ai][m] + bv[bj * 2], v1 = acc[ai][bj][m][1] * rs[ai][m] + bv[bj * 2 + 1];
          u32x4 w; w.x = pack2(v0[0], v0[1]); w.y = pack2(v0[2], v0[3]); w.z = pack2(v1[0], v1[1]); w.w = pack2(v1[2], v1[3]);
          *(u32x4*)(rowp + bj * 128) = w;
        }
      }
  }
};
struct ResPre { f32x4 gav[2], xo[4][2]; };
struct EpiRes {
  const float* xold; const float *x_prompt, *x_sample; float* xres; bf16_t* xg; float* ssq; const float* ga; const float* Gn;
  DI void pre(const pg8::Unit& u, int wr, int wc, int fr, int fq, ResPre& P) const {
    const int row0 = u.pm * 256 + wr * 64 + fr, col0 = u.pn * 128 + wc * 32 + 8 * fq;
    int ss, L, mr;
    tokinfo(u.pm * 256, ss, L, mr);
#pragma unroll
    for (int n = 0; n < 2; ++n) {
      P.gav[n] = *(const f32x4*)(ga + (size_t)mr * 6144 + col0 + n * 4);
    }
#pragma unroll
    for (int m = 0; m < 4; ++m) {
      const int row = row0 + m * 16;
      const float* xp = xold ? xold + (size_t)row * DM : (row < NCTX ? x_prompt + (size_t)row * DM : x_sample + (size_t)(row - NCTX) * DM);
#pragma unroll
      for (int n = 0; n < 2; ++n) P.xo[m][n] = *(const f32x4*)(xp + col0 + n * 4);
    }
  }
  DI void operator()(const f32x4 (&acc)[2][2][4][2], const pg8::Unit& u, int wr, int wc, int fr, int fq, const ResPre& P) const {
    const int row0 = u.pm * 256 + wr * 64 + fr, col0 = u.pn * 128 + wc * 32 + 8 * fq;
    f32x4 xo1[4][2];
    f32x4 Gv[2];
    {
      int ss, L, mr;
      tokinfo(u.pm * 256, ss, L, mr);
#pragma unroll
      for (int n = 0; n < 2; ++n) Gv[n] = Gn ? *(const f32x4*)(Gn + mr * 1024 + col0 + n * 4) : (f32x4){0.f, 0.f, 0.f, 0.f};
    }
#pragma unroll
    for (int m = 0; m < 4; ++m) {
      const int row = row0 + 128 + m * 16;
      const float* xp = xold ? xold + (size_t)row * DM : (row < NCTX ? x_prompt + (size_t)row * DM : x_sample + (size_t)(row - NCTX) * DM);
#pragma unroll
      for (int n = 0; n < 2; ++n) xo1[m][n] = *(const f32x4*)(xp + col0 + n * 4);
    }
#pragma unroll
    for (int m = 0; m < 4; ++m) { pin(xo1[m][0]); pin(xo1[m][1]); }
#pragma unroll
    for (int ai = 0; ai < 2; ++ai)
#pragma unroll
      for (int m = 0; m < 4; ++m) {
        const int row = row0 + ai * 128 + m * 16;
        const f32x4 x0 = (ai ? xo1[m][0] : P.xo[m][0]) + P.gav[0] * acc[ai][0][m][0], x1 = (ai ? xo1[m][1] : P.xo[m][1]) + P.gav[1] * acc[ai][0][m][1];
        *(f32x4*)(xres + (size_t)row * DM + col0) = x0;
        *(f32x4*)(xres + (size_t)row * DM + col0 + 4) = x1;
        float sq = ((x0[0] * x0[0] + x0[1] * x0[1]) + (x0[2] * x0[2] + x0[3] * x0[3])) + ((x1[0] * x1[0] + x1[1] * x1[1]) + (x1[2] * x1[2] + x1[3] * x1[3]));
        if (Gn) {
          const f32x4 y0 = x0 * Gv[0], y1 = x1 * Gv[1];
          u32x4 w; w.x = pack2(y0[0], y0[1]); w.y = pack2(y0[2], y0[3]); w.z = pack2(y1[0], y1[1]); w.w = pack2(y1[2], y1[3]);
          *(u32x4*)(xg + (size_t)row * DM + col0) = w;
        }
        sq += __shfl_xor(sq, 16); sq += __shfl_xor(sq, 32);
        if (fq == 0) ssq[(size_t)row * 32 + u.pn * 4 + wc] = sq;
      }
  }
};
struct EpiFfi {
  bf16_t* act; unsigned tab;
  DI void operator()(const f32x4 (&acc)[2][2][4][2], const pg8::Unit& u, int wr, int wc, int fr, int fq) const {
    const int row0 = u.pm * 256 + wr * 64 + fr;
    const int acol = 128 * u.pn + 32 * wc + 8 * fq;
    const int ui = u.idx < EPI_MAXU ? u.idx : EPI_MAXU - 1;
    float rs[2][4];
    f32x4 bv[4];
    epi_read(tab + (ui * 256 + wr * 64 + fr) * 4, tab + (EPI_MAXU * 256 + ui * 256 + wc * 32 + 8 * fq) * 4, rs, bv);
#pragma unroll
    for (int ai = 0; ai < 2; ++ai)
#pragma unroll
      for (int m = 0; m < 4; ++m) {
        const int row = row0 + ai * 128 + m * 16;
        const f32x4 g0 = acc[ai][0][m][0] * rs[ai][m] + bv[0], g1 = acc[ai][0][m][1] * rs[ai][m] + bv[1];
        const f32x4 u0 = acc[ai][1][m][0] * rs[ai][m] + bv[2], u1 = acc[ai][1][m][1] * rs[ai][m] + bv[3];
        u32x4 w;
        w.x = pack2(silu_f(g0[0]) * u0[0], silu_f(g0[1]) * u0[1]);
        w.y = pack2(silu_f(g0[2]) * u0[2], silu_f(g0[3]) * u0[3]);
        w.z = pack2(silu_f(g1[0]) * u1[0], silu_f(g1[1]) * u1[1]);
        w.w = pack2(silu_f(g1[2]) * u1[2], silu_f(g1[3]) * u1[3]);
        *(u32x4*)(act + (size_t)row * DFF + acol) = w;
      }
  }
};

DI void conv_task(const Params& p, int l, int ct, char* lds) {
  const int tid = opaque_tid(), wid = tid >> 6, lane = tid & 63, fr = lane & 15, fq = lane >> 4;
  const int T0 = ct * 32;
  int ss, L, mr;
  tokinfo(T0, ss, L, mr);
  float* hs = (float*)lds;
  float* co = (float*)lds;
  char* As = lds + 32768;
  float wk[31];
#pragma unroll
  for (int k = 0; k < 31; ++k) wk[k] = p.conv_dw[(l * 31 + k) * 256 + tid];
  const float cbias = p.conv_b[l * 256 + tid];
  const f32x4 g = *(const f32x4*)(p.conv_ln_g + l * 256 + lane * 4), bb = *(const f32x4*)(p.conv_ln_b + l * 256 + lane * 4);
#pragma unroll
  for (int ib = 0; ib < 16; ib += 16) {
    f32x4 a1[16], a2[16];
#pragma unroll
    for (int q = 0; q < 16; ++q) {
      int r = (ib + q) * 4 + (tid >> 6), c4 = (tid & 63) * 4;
      int T = T0 - 15 + r;
      bool ok = r < 62 && T >= ss && T < ss + L;
      a1[q] = ok ? ld4bf(p.proj + (size_t)T * INC + c4) : f32x4{0.f, 0.f, 0.f, 0.f};
      a2[q] = ok ? ld4bf(p.proj + (size_t)T * INC + 256 + c4) : f32x4{0.f, 0.f, 0.f, 0.f};
    }
#pragma unroll
    for (int q = 0; q < 16; ++q) {
      int r = (ib + q) * 4 + (tid >> 6), c4 = (tid & 63) * 4;
      f32x4 h;
      h.x = a1[q].x * sigmoid_f(a2[q].x); h.y = a1[q].y * sigmoid_f(a2[q].y); h.z = a1[q].z * sigmoid_f(a2[q].z); h.w = a1[q].w * sigmoid_f(a2[q].w);
      if (r < 62) *(f32x4*)(hs + r * 256 + c4) = h;
    }
  }
  lds_barrier();
  float o[32];
  {
    const int c = tid;
#pragma unroll
    for (int tt = 0; tt < 32; ++tt) o[tt] = cbias;
#pragma unroll
    for (int k = 0; k < 31; ++k) {
      const float w = wk[k];
#pragma unroll
      for (int tt = 0; tt < 32; ++tt) o[tt] += w * hs[(tt + k) * 256 + c];
    }
  }
  lds_barrier();
#pragma unroll
  for (int tt = 0; tt < 32; ++tt) co[tt * 256 + tid] = o[tt];
  lds_barrier();
  {
    f32x4 v[8];
    float s[8], s2[8];
#pragma unroll
    for (int q = 0; q < 8; ++q) { v[q] = *(const f32x4*)(co + (wid * 8 + q) * 256 + lane * 4); s[q] = (v[q].x + v[q].y) + (v[q].z + v[q].w); }
#pragma unroll
    for (int of = 32; of >= 1; of >>= 1) {
      float t[8];
#pragma unroll
      for (int q = 0; q < 8; ++q) t[q] = __shfl_xor(s[q], of);
#pragma unroll
      for (int q = 0; q < 8; ++q) s[q] += t[q];
    }
#pragma unroll
    for (int q = 0; q < 8; ++q) {
      const float mu = s[q] * (1.f / 256.f);
      v[q] = v[q] - mu;
      s2[q] = (v[q].x * v[q].x + v[q].y * v[q].y) + (v[q].z * v[q].z + v[q].w * v[q].w);
    }
#pragma unroll
    for (int of = 32; of >= 1; of >>= 1) {
      float t[8];
#pragma unroll
      for (int q = 0; q < 8; ++q) t[q] = __shfl_xor(s2[q], of);
#pragma unroll
      for (int q = 0; q < 8; ++q) s2[q] += t[q];
    }
#pragma unroll
    for (int q = 0; q < 8; ++q) {
      const int tt = wid * 8 + q;
      const float rs = rsqrtf(s2[q] * (1.f / 256.f) + EPS);
      u32x2 ov;
      ov.x = pack2(silu_f(v[q].x * rs * g.x + bb.x), silu_f(v[q].y * rs * g.y + bb.y));
      ov.y = pack2(silu_f(v[q].z * rs * g.z + bb.z), silu_f(v[q].w * rs * g.w + bb.w));
      *(u32x2*)(As + tt * 528 + lane * 8) = ov;
    }
  }
  lds_barrier();
  f32x4 acc[2][4];
#pragma unroll
  for (int m = 0; m < 2; ++m)
#pragma unroll
    for (int n = 0; n < 4; ++n) acc[m][n] = f32x4{0.f, 0.f, 0.f, 0.f};
  const bf16_t* wt = p.wt_pw + (size_t)l * 65536;
#pragma unroll
  for (int kh = 0; kh < 2; ++kh) {
    bf16x8 ball[4][4];
#pragma unroll
    for (int kk = 0; kk < 4; ++kk)
#pragma unroll
      for (int n = 0; n < 4; ++n) ball[kk][n] = *(const bf16x8*)(wt + (size_t)(wid * 64 + n * 16 + fr) * 256 + (kh * 4 + kk) * 32 + fq * 8);
#pragma unroll
    for (int kk = 0; kk < 4; ++kk) {
      const int ks = kh * 4 + kk;
      bf16x8 af[2];
#pragma unroll
      for (int m = 0; m < 2; ++m) af[m] = *(const bf16x8*)(As + (m * 16 + fr) * 528 + ks * 64 + fq * 16);
#pragma unroll
      for (int m = 0; m < 2; ++m)
#pragma unroll
        for (int n = 0; n < 4; ++n) acc[m][n] = MFMA16(af[m], ball[kk][n], acc[m][n]);
    }
  }
#pragma unroll
  for (int m = 0; m < 2; ++m)
#pragma unroll
    for (int j = 0; j < 4; ++j)
#pragma unroll
      for (int n = 0; n < 4; ++n)
        p.mix[(size_t)(T0 + m * 16 + fq * 4 + j) * DM + wid * 64 + n * 16 + fr] = f2bf(acc[m][n][j]);
  lds_barrier();
}

DI void pool_task(const Params& p, int l, int pt, char* lds) {
  const int tid = opaque_tid(), wid = tid >> 6, lane = tid & 63, fr = lane & 15, fq = lane >> 4;
  const int T0 = pt * 32;
  int ss, L, mr;
  tokinfo(T0, ss, L, mr);
  float* ps = (float*)lds;
  float scv[4];
#pragma unroll
  for (int n = 0; n < 4; ++n) scv[n] = p.pool_scale[l * 256 + wid * 64 + n * 16 + fr];
  char* As = lds + 49152;
#pragma unroll
  for (int ib = 0; ib < 12; ib += 12) {
    f32x4 v[12];
#pragma unroll
    for (int q = 0; q < 12; ++q) {
      int r = (ib + q) * 4 + (tid >> 6), c4 = (tid & 63) * 4;
      int T = T0 - 8 + r;
      bool ok = T >= ss && T < ss + L;
      v[q] = ok ? ld4bf(p.proj + (size_t)T * INC + 1024 + c4) : f32x4{0.f, 0.f, 0.f, 0.f};
    }
#pragma unroll
    for (int q = 0; q < 12; ++q) {
      int r = (ib + q) * 4 + (tid >> 6), c4 = (tid & 63) * 4;
      *(f32x4*)(ps + r * 256 + c4) = v[q];
    }
  }
  lds_barrier();
  {
    const int c = tid, gi = wid, hw = 1 << gi;
    const int tl0 = T0 - ss;
    float s = 0.f;
    for (int r = 8 - hw; r < 8 + hw; ++r) s += ps[r * 256 + c];
#pragma unroll 8
    for (int tt = 0; tt < 32; ++tt) {
      int t = tl0 + tt;
      int lo = max(t - hw, 0), hi = min(t + hw, L);
      float d = s / (float)(hi - lo) - ps[(tt + 8) * 256 + c];
      *(bf16_t*)(As + tt * 528 + c * 2) = f2bf(d);
      s += ps[(tt + 8 + hw) * 256 + c] - ps[(tt + 8 - hw) * 256 + c];
    }
  }
  lds_barrier();
  f32x4 acc[2][4];
#pragma unroll
  for (int m = 0; m < 2; ++m)
#pragma unroll
    for (int n = 0; n < 4; ++n) acc[m][n] = f32x4{0.f, 0.f, 0.f, 0.f};
  const bf16_t* wt = p.wt_pool + (size_t)(l * 4 + wid) * 4096;
#pragma unroll
  for (int ks = 0; ks < 2; ++ks) {
    bf16x8 af[2], bfr[4];
#pragma unroll
    for (int m = 0; m < 2; ++m) af[m] = *(const bf16x8*)(As + (m * 16 + fr) * 528 + (wid * 64 + ks * 32 + fq * 8) * 2);
#pragma unroll
    for (int n = 0; n < 4; ++n) bfr[n] = *(const bf16x8*)(wt + (n * 16 + fr) * 64 + ks * 32 + fq * 8);
#pragma unroll
    for (int m = 0; m < 2; ++m)
#pragma unroll
      for (int n = 0; n < 4; ++n) acc[m][n] = MFMA16(af[m], bfr[n], acc[m][n]);
  }
#pragma unroll
  for (int n = 0; n < 4; ++n) {
    int col = wid * 64 + n * 16 + fr;
    float sc = scv[n];
#pragma unroll
    for (int m = 0; m < 2; ++m)
#pragma unroll
      for (int j = 0; j < 4; ++j)
        p.mix[(size_t)(T0 + m * 16 + fq * 4 + j) * DM + 512 + col] = f2bf(acc[m][n][j] * sc);
  }
  lds_barrier();
}

DI void stage_vT(const bf16_t* src  , char* vT) {
  const int tid = opaque_tid();
  u32x2 vv[8];
#pragma unroll
  for (int i = 0; i < 8; ++i) { int idx = tid + 256 * i; vv[i] = *(const u32x2*)(src + (size_t)(idx >> 4) * INC + (idx & 15) * 4); }
#pragma unroll
  for (int i = 0; i < 8; ++i) {
    int idx = tid + 256 * i, q = idx >> 4, d4 = (idx & 15) * 4;
    const u32x2 v = vv[i];
    *(bf16_t*)(vT + (d4 + 0) * 272 + q * 2) = (bf16_t)(v.x & 0xffffu);
    *(bf16_t*)(vT + (d4 + 1) * 272 + q * 2) = (bf16_t)(v.x >> 16);
    *(bf16_t*)(vT + (d4 + 2) * 272 + q * 2) = (bf16_t)(v.y & 0xffffu);
    *(bf16_t*)(vT + (d4 + 3) * 272 + q * 2) = (bf16_t)(v.y >> 16);
  }
}

DI void gmlp_task(const Params& p, int l, int cgi, int h, char* lds) {
  const int tid = opaque_tid(), wid = tid >> 6, lane = tid & 63, fr = lane & 15, fq = lane >> 4;
  const int T0 = cgi * 128;
  char* vT = lds;
  const float* wsb = p.gmlp_ws + (size_t)(l * 4 + h) * 16384;
  f32x4 araw[4][2][2];
#pragma unroll
  for (int ks = 0; ks < 4; ++ks)
#pragma unroll
    for (int m = 0; m < 2; ++m) {
      const float* ap = wsb + (wid * 32 + m * 16 + fr) * 128 + ks * 32 + fq * 8;
      araw[ks][m][0] = *(const f32x4*)ap; araw[ks][m][1] = *(const f32x4*)(ap + 4);
    }
  bf16_t uraw[2][4][4];
  float braw[2][4];
#pragma unroll
  for (int m = 0; m < 2; ++m)
#pragma unroll
    for (int j = 0; j < 4; ++j) {
      int pp = wid * 32 + m * 16 + fq * 4 + j;
      braw[m][j] = p.gmlp_b[(l * 4 + h) * 128 + pp];
#pragma unroll
      for (int n = 0; n < 4; ++n) uraw[m][j][n] = p.proj[(size_t)(T0 + pp) * INC + 512 + h * 64 + n * 16 + fr];
    }
  stage_vT(p.proj + (size_t)T0 * INC + 768 + h * 64, vT);
  lds_barrier();
  f32x4 acc[2][4];
#pragma unroll
  for (int m = 0; m < 2; ++m)
#pragma unroll
    for (int n = 0; n < 4; ++n) acc[m][n] = f32x4{0.f, 0.f, 0.f, 0.f};
#pragma unroll
  for (int ks = 0; ks < 4; ++ks) {
    bf16x8 af[2], bfr[4];
#pragma unroll
    for (int m = 0; m < 2; ++m) {
      const f32x4 a = araw[ks][m][0], b = araw[ks][m][1];
      u32x4 u;
      u.x = pack2(a.x, a.y); u.y = pack2(a.z, a.w); u.z = pack2(b.x, b.y); u.w = pack2(b.z, b.w);
      af[m] = __builtin_bit_cast(bf16x8, u);
    }
#pragma unroll
    for (int n = 0; n < 4; ++n) bfr[n] = *(const bf16x8*)(vT + (n * 16 + fr) * 272 + ks * 64 + fq * 16);
#pragma unroll
    for (int m = 0; m < 2; ++m)
#pragma unroll
      for (int n = 0; n < 4; ++n) acc[m][n] = MFMA16(af[m], bfr[n], acc[m][n]);
  }
#pragma unroll
  for (int m = 0; m < 2; ++m)
#pragma unroll
    for (int j = 0; j < 4; ++j) {
      int pp = wid * 32 + m * 16 + fq * 4 + j;
#pragma unroll
      for (int n = 0; n < 4; ++n) {
        int d = n * 16 + fr;
        p.mix[(size_t)(T0 + pp) * DM + 256 + h * 64 + d] = f2bf(bf2f(uraw[m][j][n]) * (acc[m][n][j] + braw[m][j]));
      }
    }
  lds_barrier();
}

DI void rope_load(const Params& p, const bf16_t* src  , bool rot, int pos, int i4, f32x4& o1, f32x4& o2) {
  f32x4 x1 = ld4bf(src), x2 = ld4bf(src + 16);
  if (rot) {
    const f32x4* cs = (const f32x4*)(p.rope + (pos * 16 + 4 * i4) * 2);
    f32x4 c01 = cs[0], c23 = cs[1];
    o1.x = x1.x * c01.x - x2.x * c01.y; o2.x = x1.x * c01.y + x2.x * c01.x;
    o1.y = x1.y * c01.z - x2.y * c01.w; o2.y = x1.y * c01.w + x2.y * c01.z;
    o1.z = x1.z * c23.x - x2.z * c23.y; o2.z = x1.z * c23.y + x2.z * c23.x;
    o1.w = x1.w * c23.z - x2.w * c23.w; o2.w = x1.w * c23.w + x2.w * c23.z;
  } else { o1 = x1; o2 = x2; }
}

DI void kv_task(const Params& p, int l, int cgi, int h, int dir, char* lds) {
  const int tid = opaque_tid(), wid = tid >> 6, lane = tid & 63, fr = lane & 15, fq = lane >> 4;
  const int T0 = cgi * 128;
  int ss, L, mr;
  tokinfo(T0, ss, L, mr);
  const bool rot = mr > 0;
  const float lg = loggamma(p, l, dir, h);
  char* kT = lds;
  char* vT = lds + 17408;
  stage_vT(p.proj + (size_t)T0 * INC + 2304 + h * 64, vT);
  const int kcol = 1280 + (dir ? 768 : 256) + h * 64;
  f32x4 ko1[4], ko2[4];
#pragma unroll
  for (int it = 0; it < 4; ++it) {
    int idx = tid + 256 * it, j = idx >> 3, hf = (idx >> 2) & 1, i4 = idx & 3;
    int tl = T0 - ss + j;
    int pos = hf ? (tl & 63) : (tl >> 6);
    rope_load(p, p.proj + (size_t)(T0 + j) * INC + kcol + 32 * hf + 4 * i4, rot, pos, i4, ko1[it], ko2[it]);
  }
#pragma unroll
  for (int it = 0; it < 4; ++it) {
    int idx = tid + 256 * it, j = idx >> 3, hf = (idx >> 2) & 1, i4 = idx & 3;
    const f32x4 o1 = ko1[it], o2 = ko2[it];
    float wj = __expf(lg * (float)(dir ? j : 127 - j)) * 0.125f;
    int d1 = 32 * hf + 4 * i4, d2 = d1 + 16;
    *(bf16_t*)(kT + (d1 + 0) * 272 + j * 2) = f2bf(o1.x * wj);
    *(bf16_t*)(kT + (d1 + 1) * 272 + j * 2) = f2bf(o1.y * wj);
    *(bf16_t*)(kT + (d1 + 2) * 272 + j * 2) = f2bf(o1.z * wj);
    *(bf16_t*)(kT + (d1 + 3) * 272 + j * 2) = f2bf(o1.w * wj);
    *(bf16_t*)(kT + (d2 + 0) * 272 + j * 2) = f2bf(o2.x * wj);
    *(bf16_t*)(kT + (d2 + 1) * 272 + j * 2) = f2bf(o2.y * wj);
    *(bf16_t*)(kT + (d2 + 2) * 272 + j * 2) = f2bf(o2.z * wj);
    *(bf16_t*)(kT + (d2 + 3) * 272 + j * 2) = f2bf(o2.w * wj);
  }
  lds_barrier();
  f32x4 acc[4];
#pragma unroll
  for (int n = 0; n < 4; ++n) acc[n] = f32x4{0.f, 0.f, 0.f, 0.f};
#pragma unroll
  for (int ks = 0; ks < 4; ++ks) {
    bf16x8 af = *(const bf16x8*)(kT + (wid * 16 + fr) * 272 + ks * 64 + fq * 16);
#pragma unroll
    for (int n = 0; n < 4; ++n) {
      bf16x8 bfr = *(const bf16x8*)(vT + (n * 16 + fr) * 272 + ks * 64 + fq * 16);
      acc[n] = MFMA16(af, bfr, acc[n]);
    }
  }
  float* kv = p.KV + (size_t)((cgi * 4 + h) * 2 + dir) * 4096;
#pragma unroll
  for (int n = 0; n < 4; ++n)
#pragma unroll
    for (int j = 0; j < 4; ++j) kv[(wid * 16 + fq * 4 + j) * 64 + n * 16 + fr] = acc[n][j];
  lds_barrier();
}

DI void ret_task(const Params& p, int l, int cgi, int h, int dir, char* lds, char* lds_partner) {
  const int tid = opaque_tid(), wid = __builtin_amdgcn_readfirstlane(tid >> 6), lane = tid & 63, fr = lane & 15, fq = lane >> 4;
  const int T0 = cgi * 128;
  int ss, L, mr;
  tokinfo(T0, ss, L, mr);
  const bool rot = mr > 0;
  const int nc = L >> 7, c = (T0 - ss) >> 7, cg0 = ss >> 7;
  const int i0 = wid * 32;
  char* Qs = lds;
  char* Ks = lds + 18432;
  char* vT = lds + 36864;
  char* ST = lds + 54272;
  char* att = lds + 63488 + wid * 2560;
  f32x4 o[2][4];
#pragma unroll
  for (int m = 0; m < 2; ++m)
#pragma unroll
    for (int n = 0; n < 4; ++n) o[m][n] = f32x4{0.f, 0.f, 0.f, 0.f};
  stage_vT(p.proj + (size_t)T0 * INC + 2304 + h * 64, vT);
  const float lg = loggamma(p, l, dir, h);
  {
    float s[16];
    const float* s0 = rot ? p.state_ret + (size_t)((((mr - 1) * 2 + l) * 2 + dir) * 4 + h) * 4096 : nullptr;
    const float f0 = __expf(lg * 128.f * (float)(dir ? nc - 1 - c : c));
#pragma unroll
    for (int i = 0; i < 16; ++i) s[i] = s0 ? s0[tid + 256 * i] * f0 : 0.f;
    const int mlo = dir ? c + 1 : 0, mhi = dir ? nc : c;
#pragma unroll 1
    for (int mb = mlo; mb < mhi; mb += 4) {
      float kvv[4][16], f[4];
#pragma unroll
      for (int q = 0; q < 4; ++q) {
        const int m = min(mb + q, mhi - 1);
        f[q] = (mb + q < mhi) ? __expf(lg * 128.f * (float)(dir ? m - c - 1 : c - 1 - m)) : 0.f;
        const float* kv = p.KV + (size_t)(((cg0 + m) * 4 + h) * 2 + dir) * 4096 + tid;
#pragma unroll
        for (int i = 0; i < 16; ++i) kvv[q][i] = kv[256 * i];
      }
#pragma unroll
      for (int q = 0; q < 4; ++q)
#pragma unroll
        for (int i = 0; i < 16; ++i) s[i] += kvv[q][i] * f[q];
    }
#pragma unroll
    for (int i = 0; i < 16; ++i) {
      int el = tid + 256 * i, d = el >> 6, e = el & 63;
      *(bf16_t*)(ST + e * 144 + d * 2) = f2bf(s[i]);
    }
    if (!rot && c == 0) {
#pragma unroll
      for (int i = 0; i < 16; ++i) s[i] = 0.f;
#pragma unroll 1
      for (int m = 0; m < nc; ++m) {
        const float f = __expf(lg * 128.f * (float)(dir ? m : nc - 1 - m));
        const float* kv = p.KV + (size_t)(((cg0 + m) * 4 + h) * 2 + dir) * 4096 + tid;
#pragma unroll
        for (int i = 0; i < 16; ++i) s[i] += kv[256 * i] * f;
      }
      const int b = ss >> 8;
      float* op = p.out + (size_t)NTOK * DM + (size_t)((((b * 2 + l) * 2 + dir) * 4 + h)) * 4096 + tid;
#pragma unroll
      for (int i = 0; i < 16; ++i) op[256 * i] = s[i];
    }
  }
  {
    const int qcol = 1280 + (dir ? 512 : 0) + h * 64, kcol = qcol + 256;
    f32x4 q1[4], q2[4], k1[4], k2[4];
#pragma unroll
    for (int it = 0; it < 4; ++it) {
      int idx = tid + 256 * it, j = idx >> 3, hf = (idx >> 2) & 1, i4 = idx & 3;
      int tl = T0 - ss + j;
      int pos = hf ? (tl & 63) : (tl >> 6);
      const bf16_t* rowp = p.proj + (size_t)(T0 + j) * INC + 32 * hf + 4 * i4;
      rope_load(p, rowp + qcol, rot, pos, i4, q1[it], q2[it]);
      rope_load(p, rowp + kcol, rot, pos, i4, k1[it], k2[it]);
    }
#pragma unroll
    for (int it = 0; it < 4; ++it) {
      int idx = tid + 256 * it, j = idx >> 3, hf = (idx >> 2) & 1, i4 = idx & 3;
      f32x4 o1 = q1[it], o2 = q2[it];
      u32x2 u1, u2;
      u1.x = pack2(o1.x, o1.y); u1.y = pack2(o1.z, o1.w); u2.x = pack2(o2.x, o2.y); u2.y = pack2(o2.z, o2.w);
      *(u32x2*)(Qs + j * 144 + (32 * hf + 4 * i4) * 2) = u1;
      *(u32x2*)(Qs + j * 144 + (32 * hf + 16 + 4 * i4) * 2) = u2;
      o1 = k1[it]; o2 = k2[it];
      u1.x = pack2(o1.x * 0.125f, o1.y * 0.125f); u1.y = pack2(o1.z * 0.125f, o1.w * 0.125f);
      u2.x = pack2(o2.x * 0.125f, o2.y * 0.125f); u2.y = pack2(o2.z * 0.125f, o2.w * 0.125f);
      *(u32x2*)(Ks + j * 144 + (32 * hf + 4 * i4) * 2) = u1;
      *(u32x2*)(Ks + j * 144 + (32 * hf + 16 + 4 * i4) * 2) = u2;
    }
  }
  lds_barrier();
  bf16_t graw[2][4][4];
#pragma unroll
  for (int m = 0; m < 2; ++m)
#pragma unroll
    for (int j = 0; j < 4; ++j) {
      const bf16_t* gp = p.proj + (size_t)(T0 + i0 + m * 16 + fq * 4 + j) * INC + 2560 + h * 64 + fr;
#pragma unroll
      for (int n = 0; n < 4; ++n) graw[m][j][n] = gp[16 * n];
    }
  bf16x8 qf[2][2];
#pragma unroll
  for (int m = 0; m < 2; ++m)
#pragma unroll
    for (int ks = 0; ks < 2; ++ks) qf[m][ks] = *(const bf16x8*)(Qs + (i0 + m * 16 + fr) * 144 + ks * 64 + fq * 16);
  {
#pragma unroll
    for (int ks = 0; ks < 2; ++ks)
#pragma unroll
      for (int n = 0; n < 4; ++n) {
        bf16x8 bfr = *(const bf16x8*)(ST + (n * 16 + fr) * 144 + ks * 64 + fq * 16);
#pragma unroll
        for (int m = 0; m < 2; ++m) o[m][n] = MFMA16(qf[m][ks], bfr, o[m][n]);
      }
#pragma unroll
    for (int m = 0; m < 2; ++m)
#pragma unroll
      for (int j = 0; j < 4; ++j) {
        int i = i0 + m * 16 + fq * 4 + j;
        float rsf = __expf(lg * (float)(dir ? 128 - i : i + 1));
#pragma unroll
        for (int n = 0; n < 4; ++n) o[m][n][j] *= rsf;
      }
  }
  const int jlo = dir ? wid : 0, jhi = dir ? 3 : wid;
#pragma unroll 1
  for (int jb = jlo; jb <= jhi; ++jb) {
    f32x4 s[2][2];
#pragma unroll
    for (int m = 0; m < 2; ++m)
#pragma unroll
      for (int n = 0; n < 2; ++n) s[m][n] = f32x4{0.f, 0.f, 0.f, 0.f};
#pragma unroll
    for (int ks = 0; ks < 2; ++ks)
#pragma unroll
      for (int n = 0; n < 2; ++n) {
        bf16x8 bfr = *(const bf16x8*)(Ks + (jb * 32 + n * 16 + fr) * 144 + ks * 64 + fq * 16);
#pragma unroll
        for (int m = 0; m < 2; ++m) s[m][n] = MFMA16(qf[m][ks], bfr, s[m][n]);
      }
#pragma unroll
    for (int m = 0; m < 2; ++m)
#pragma unroll
      for (int n = 0; n < 2; ++n)
#pragma unroll
        for (int j = 0; j < 4; ++j) {
          int i = i0 + m * 16 + fq * 4 + j, jj = jb * 32 + n * 16 + fr;
          int df = dir ? jj - i : i - jj;
          float dec = df >= 0 ? __expf(lg * (float)df) : 0.f;
          *(bf16_t*)(att + (m * 16 + fq * 4 + j) * 80 + (n * 16 + fr) * 2) = f2bf(s[m][n][j] * dec);
        }
    asm volatile("s_waitcnt lgkmcnt(0)" ::: "memory");
    bf16x8 af[2];
#pragma unroll
    for (int m = 0; m < 2; ++m) af[m] = *(const bf16x8*)(att + (m * 16 + fr) * 80 + fq * 16);
#pragma unroll
    for (int n = 0; n < 4; ++n) {
      bf16x8 bfr = *(const bf16x8*)(vT + (n * 16 + fr) * 272 + (jb * 32 + fq * 8) * 2);
#pragma unroll
      for (int m = 0; m < 2; ++m) o[m][n] = MFMA16(af[m], bfr, o[m][n]);
    }
    asm volatile("s_waitcnt lgkmcnt(0)" ::: "memory");
  }
  lds_barrier();
  const bool mine = (wid >> 1) == dir;
  if (!mine) {
    float* ex = (float*)lds_partner + ((wid & 1) * 32) * 64 + lane;
#pragma unroll
    for (int m = 0; m < 2; ++m)
#pragma unroll
      for (int n = 0; n < 4; ++n)
#pragma unroll
        for (int j = 0; j < 4; ++j) ex[(m * 16 + n * 4 + j) * 64] = o[m][n][j];
  }
  lds_barrier();
  if (mine) {
    const float* ex = (const float*)lds + ((wid & 1) * 32) * 64 + lane;
#pragma unroll
    for (int m = 0; m < 2; ++m)
#pragma unroll
      for (int n = 0; n < 4; ++n)
#pragma unroll
        for (int j = 0; j < 4; ++j) o[m][n][j] += ex[(m * 16 + n * 4 + j) * 64];
    float gs[2][4], gq[2][4];
#pragma unroll
    for (int m = 0; m < 2; ++m)
#pragma unroll
      for (int j = 0; j < 4; ++j) gs[m][j] = (o[m][0][j] + o[m][1][j]) + (o[m][2][j] + o[m][3][j]);
#pragma unroll
    for (int of = 1; of <= 8; of <<= 1) {
      float t[2][4];
#pragma unroll
      for (int m = 0; m < 2; ++m)
#pragma unroll
        for (int j = 0; j < 4; ++j) t[m][j] = __shfl_xor(gs[m][j], of);
#pragma unroll
      for (int m = 0; m < 2; ++m)
#pragma unroll
        for (int j = 0; j < 4; ++j) gs[m][j] += t[m][j];
    }
#pragma unroll
    for (int m = 0; m < 2; ++m)
#pragma unroll
      for (int j = 0; j < 4; ++j) {
        const float mu = gs[m][j] * (1.f / 64.f);
#pragma unroll
        for (int n = 0; n < 4; ++n) o[m][n][j] -= mu;
        gq[m][j] = (o[m][0][j] * o[m][0][j] + o[m][1][j] * o[m][1][j]) + (o[m][2][j] * o[m][2][j] + o[m][3][j] * o[m][3][j]);
      }
#pragma unroll
    for (int of = 1; of <= 8; of <<= 1) {
      float t[2][4];
#pragma unroll
      for (int m = 0; m < 2; ++m)
#pragma unroll
        for (int j = 0; j < 4; ++j) t[m][j] = __shfl_xor(gq[m][j], of);
#pragma unroll
      for (int m = 0; m < 2; ++m)
#pragma unroll
        for (int j = 0; j < 4; ++j) gq[m][j] += t[m][j];
    }
#pragma unroll
    for (int m = 0; m < 2; ++m)
#pragma unroll
      for (int j = 0; j < 4; ++j) {
        const float rs = rsqrtf(gq[m][j] * (1.f / 64.f) + EPS);
        const int T = T0 + i0 + m * 16 + fq * 4 + j;
        bf16_t* mp = p.mix + (size_t)T * DM + 768 + h * 64 + fr;
        mp[0] = f2bf(silu_f(bf2f(graw[m][j][0])) * o[m][0][j] * rs);
        mp[16] = f2bf(silu_f(bf2f(graw[m][j][1])) * o[m][1][j] * rs);
        mp[32] = f2bf(silu_f(bf2f(graw[m][j][2])) * o[m][2][j] * rs);
        mp[48] = f2bf(silu_f(bf2f(graw[m][j][3])) * o[m][3][j] * rs);
      }
  }
  lds_barrier();
}

DI void phase_final(const Params& p, int vbi, int nvb) {
  const int tid = opaque_tid(), wid = tid >> 6, lane = tid & 63;
  for (int t = vbi; t < NTOK / 4; t += nvb) {
    int T = t * 4 + wid;
    f32x4 xv[4], gv[4];
#pragma unroll
    for (int i = 0; i < 4; ++i) { int k = i * 256 + lane * 4; xv[i] = *(const f32x4*)(p.xres + (size_t)T * DM + k); gv[i] = *(const f32x4*)(p.g_final + k); }
    float rs = row_rstd(p.ssq, T);
#pragma unroll
    for (int i = 0; i < 4; ++i) { pin(xv[i]); pin(gv[i]); }
#pragma unroll
    for (int i = 0; i < 4; ++i) {
      int k = i * 256 + lane * 4;
      f32x4 v = xv[i];
      f32x4 g = gv[i];
      f32x4 y = f32x4{v.x * rs * g.x, v.y * rs * g.y, v.z * rs * g.z, v.w * rs * g.w};
      *(f32x4*)(p.out + (size_t)T * DM + k) = y;
    }
  }
}

__global__ void __launch_bounds__(512, 2) mega(Params p, int ph_lo, int ph_hi) {
  __shared__ __attribute__((aligned(16))) char lds_all[2 * 73728];
  __shared__ u32x4 xb_words;
  cg::grid_group grid = cg::this_grid();
  if (threadIdx.x == 0) xb_words = u32x4{0u, 0u, 0u, 0u};
  __syncthreads();
  XcdBarrier xb = xcd_barrier_post(p.bar, (volatile LAS unsigned*)&xb_words);
  if (ph_hi > NPH) grid.sync();
  LAS unsigned char* glds = (LAS unsigned char*)lds_all;
  for (int ph = ph_lo; ph < ph_hi; ++ph) {
    if (ph > ph_lo) xcd_barrier(xb);
    int bid = blockIdx.x, vb = (int)(threadIdx.x >> 8);
    asm volatile("" : "+s"(bid));
    asm volatile("" : "+v"(vb));
    vb = __builtin_amdgcn_readfirstlane(vb);
    char* lds = lds_all + vb * 73728;
    const int vbi = bid * 2 + vb, nvb = gridDim.x * 2;
    if (ph == 0) phase_prep0(p, lds, vbi, nvb);
    else if (ph == 1) phase_prep1(p, lds, vbi, nvb);
    else if (ph == NPH - 1) phase_final(p, vbi, nvb);
    else {
      const int l = (ph - 2) / 6, sub = (ph - 2) % 6;
      pg8::StaticOrder S;
      if (sub == 0) {
        pg8::Gemm g{p.xg, p.wt_in + (size_t)l * INC * 1024, NTOK, INC, 1024};
        S.init(NTOK, INC, 256, gridDim.x, bid, 4);
        epi_tables(lds_all + 131072, S, p.ssq, p.biasIn + (size_t)l * 5 * INC, false);
        EpiIn E{p.proj, (unsigned)(size_t)(glds + 131072)};
        pg8::gemm_phase<2>(glds, g, S, E);
        const int lo_in = gridDim.x == 256 ? 96 : 0;
        if (bid >= lo_in) {
          DecRest dec{&p, l};
          transpose_run((bid - lo_in) * 2 + vb, 2368, (gridDim.x - lo_in) * 2, dec, lds);
        }
      } else if (sub == 1) {
        for (int b = bid; b < 256; b += gridDim.x) {
          const int g = b >> 1;
          if ((b & 1) == 0) {
            conv_task(p, l, 2 * g + vb, lds);
            { int u = 2 * g + vb; kv_task(p, l, u >> 3, (u >> 1) & 3, u & 1, lds); }
          } else {
            { int u = 2 * g + vb; gmlp_task(p, l, u >> 2, u & 3, lds); }
            pool_task(p, l, 2 * g + vb, lds);
            { int u = 256 + 2 * g + vb; kv_task(p, l, u >> 3, (u >> 1) & 3, u & 1, lds); }
          }
        }
      } else if (sub == 2) {
        for (int t = vbi; t < 176; t += nvb) bias_task(p, l, 1, t);
        for (int b = bid; b < 256; b += gridDim.x) ret_task(p, l, b >> 2, b & 3, vb, lds, lds_all + (1 - vb) * 73728);
      } else if (sub == 3) {
        pg8::Gemm g{p.mix, p.wt_out + (size_t)l * 1024 * 1024, NTOK, 1024, 1024};
        S.init(NTOK, 1024, 128, gridDim.x, bid, 4);
        EpiRes E{l == 0 ? nullptr : p.xres, p.x_prompt, p.x_sample, p.xres, p.xg, p.ssq, p.mod + (size_t)l * 5 * 6144 + 2048, p.G2 + l * 5 * 1024};
        pg8::gemm_phase_n128<ResPre>(glds, g, S, E);
      } else if (sub == 4) {
        pg8::Gemm g{p.xg, p.wt_ffi + (size_t)l * 5632 * 1024, NTOK, 5632, 1024};
        S.init(NTOK, 5632, 256, gridDim.x, bid, 4);
        epi_tables(lds_all + 131072, S, p.ssq, p.biasFf + (size_t)l * 5 * 5632, true);
        EpiFfi E{p.act, (unsigned)(size_t)(glds + 131072)};
        pg8::gemm_phase<2>(glds, g, S, E);
        const int lo_ff = gridDim.x == 256 ? 192 : 0;
        if (l == 0 && bid >= lo_ff) {
          DecIn1 dec{&p};
          transpose_run((bid - lo_ff) * 2 + vb, 704, (gridDim.x - lo_ff) * 2, dec, lds);
        }
      } else {
        if (l == 0) for (int t = vbi; t < 88; t += nvb) bias_task(p, 1, 0, t);
        pg8::Gemm g{p.act, p.wt_ffo + (size_t)l * 1024 * DFF, NTOK, 1024, DFF};
        S.init(NTOK, 1024, 128, gridDim.x, bid, 4);
        EpiRes E{p.xres, p.x_prompt, p.x_sample, p.xres, p.xg, p.ssq, p.mod + (size_t)l * 5 * 6144 + 5120, l == 0 ? p.G1 + 5 * 1024 : nullptr};
        pg8::gemm_phase_n128<ResPre>(glds, g, S, E);
      }
    }
  }
}

extern "C" void kernel_launch(void* const* d_in, const int* in_sizes, int n_in, void* d_out, int out_size, void* d_ws,
                              size_t ws_size, hipStream_t stream) {
  static int grid_blocks = 0;
  if (!grid_blocks) {
    int dev = 0, cus = 0, per_cu = 0;
    hipGetDevice(&dev);
    hipDeviceGetAttribute(&cus, hipDeviceAttributeMultiprocessorCount, dev);
    hipOccupancyMaxActiveBlocksPerMultiprocessor(&per_cu, mega, 512, 0);
    if (per_cu > 1) per_cu = 1;
    if (per_cu < 1) per_cu = 1;
    grid_blocks = cus * per_cu;
  }
  Params p{};
  const float** ip = (const float**)&p;
  for (int i = 0; i < 24; ++i) ip[i] = (const float*)d_in[i];
  p.out = (float*)d_out;
  char* w = (char*)d_ws;
  size_t off = 0;
  auto take = [&](size_t bytes) { char* r = w + off; off += (bytes + 255) & ~(size_t)255; return r; };
  p.wt_in = (bf16_t*)take((size_t)2 * INC * 1024 * 2);
  p.wt_out = (bf16_t*)take((size_t)2 * 1024 * 1024 * 2);
  p.wt_ffi = (bf16_t*)take((size_t)2 * 5632 * 1024 * 2);
  p.wt_ffo = (bf16_t*)take((size_t)2 * 1024 * DFF * 2);
  p.wt_pw = (bf16_t*)take((size_t)2 * 65536 * 2);
  p.wt_pool = (bf16_t*)take((size_t)2 * 4 * 4096 * 2);
  p.mod = (float*)take((size_t)2 * 5 * 6144 * 4);
  p.G1 = (float*)take((size_t)2 * 5 * 1024 * 4);
  p.G2 = (float*)take((size_t)2 * 5 * 1024 * 4);
  p.biasIn = (float*)take((size_t)2 * 5 * INC * 4);
  p.biasFf = (float*)take((size_t)2 * 5 * 5632 * 4);
  p.rope = (float*)take((size_t)64 * 16 * 2 * 4);
  p.xg = (bf16_t*)take((size_t)NTOK * DM * 2);
  p.ssq = (float*)take((size_t)NTOK * 32 * 4);
  p.xres = (float*)take((size_t)NTOK * DM * 4);
  p.proj = (bf16_t*)take((size_t)NTOK * INC * 2);
  p.act = p.proj;
  p.mix = (bf16_t*)take((size_t)NTOK * DM * 2);
  p.KV = (float*)take((size_t)512 * 4096 * 4);
  p.bar = (unsigned*)take((size_t)XCD_BAR_WORDS * 4);
  hipMemsetAsync(p.bar, 0, (size_t)XCD_BAR_WORDS * 4, stream);
#if SINGLE_LAUNCH
  int lo = 0, hi = NPH;
  void* args[] = {&p, &lo, &hi};
  hipError_t e = hipLaunchCooperativeKernel((void*)mega, dim3(grid_blocks), dim3(512), args, 0, stream);
  if (e != hipSuccess) fprintf(stderr, "cooperative launch failed: %s (grid %d)\n", hipGetErrorString(e), grid_blocks);
#else
  for (int ph = 0; ph < NPH; ++ph) {
    int lo = ph, hi = ph + 1;
    void* args[] = {&p, &lo, &hi};
    hipError_t e = hipLaunchCooperativeKernel((void*)mega, dim3(grid_blocks), dim3(512), args, 0, stream);
    if (e != hipSuccess) fprintf(stderr, "cooperative launch failed: %s (grid %d)\n", hipGetErrorString(e), grid_blocks);
  }
#endif
}
```

```cpp
#include <hip/hip_runtime.h>
#include <hip/hip_cooperative_groups.h>
#include <cstdio>
namespace cg = cooperative_groups;

typedef unsigned short bf16_t;
using bf16x8 = __attribute__((ext_vector_type(8))) short;
using f32x4 = __attribute__((ext_vector_type(4))) float;
using u32x4 = __attribute__((ext_vector_type(4))) unsigned;
using u32x2 = __attribute__((ext_vector_type(2))) unsigned;
#define DI __device__ __forceinline__
#define MFMA16(a, b, c) __builtin_amdgcn_mfma_f32_16x16x32_bf16((a), (b), (c), 0, 0, 0)

#ifndef SINGLE_LAUNCH
#define SINGLE_LAUNCH 1
#endif

constexpr int DM = 1024, NTOK = 8192, NCTX = 4096, INC = 2816, DFF = 2816;
constexpr int NPH = 15;
constexpr float EPS = 1e-6f;

struct Params {
  const float *x_prompt, *x_sample, *state_ret, *c, *c_ctx, *w_ada, *b_ada, *g_norm1, *g_norm2, *w_in, *w_out, *conv_dw,
      *conv_b, *conv_ln_g, *conv_ln_b, *conv_pw, *gmlp_ws, *gmlp_b, *pool_w, *pool_scale, *ret_decay, *w_ffn_in, *w_ffn_out,
      *g_final;
  float* out;
  bf16_t *wt_in, *wt_out, *wt_ffi, *wt_ffo, *wt_pw, *wt_pool;
  float *mod, *G1, *G2, *biasIn, *biasFf, *rope;
  bf16_t* xg;
  float *ssq, *xres;
  bf16_t* proj;
  bf16_t *mix, *act;
  float* KV;
  unsigned* bar;
};

DI int opaque_tid() { int t = threadIdx.x & 255; asm volatile("" : "+v"(t)); return t; }
DI void lds_barrier() { asm volatile("s_waitcnt lgkmcnt(0)" ::: "memory"); __builtin_amdgcn_s_barrier(); asm volatile("" ::: "memory"); }
typedef __bf16 bf16x2_t __attribute__((ext_vector_type(2)));
typedef float f32x2_t __attribute__((ext_vector_type(2)));
DI unsigned pack2(float a, float b) { f32x2_t v = {a, b}; return __builtin_bit_cast(unsigned, __builtin_convertvector(v, bf16x2_t)); }
DI unsigned short f2bf(float x) { return (unsigned short)(pack2(x, x) & 0xffffu); }
DI float bf2f(bf16_t x) { return __uint_as_float((unsigned)x << 16); }
DI f32x4 ld4bf(const bf16_t* p) {
  const u32x2 v = *(const u32x2*)p;
  return f32x4{__uint_as_float(v.x << 16), __uint_as_float(v.x & 0xffff0000u), __uint_as_float(v.y << 16), __uint_as_float(v.y & 0xffff0000u)};
}
DI void pin(f32x4& x) { asm volatile("" : "+v"(x)); }
DI float silu_f(float v) { return v * __builtin_amdgcn_rcpf(1.f + __expf(-v)); }
DI float sigmoid_f(float v) { return __builtin_amdgcn_rcpf(1.f + __expf(-v)); }

DI void tokinfo(int T, int& seqstart, int& L, int& mr) {
  if (T < NCTX) { seqstart = T & ~255; L = 256; mr = 0; }
  else { int u = T - NCTX; seqstart = NCTX + (u & ~1023); L = 1024; mr = 1 + (u >> 10); }
}
DI const float* xin_row(const Params& p, int T) {
  return T < NCTX ? p.x_prompt + (size_t)T * DM : p.x_sample + (size_t)(T - NCTX) * DM;
}
DI float loggamma(const Params& p, int l, int dir, int h) {
  float x = p.ret_decay[(l * 2 + dir) * 4 + h];
  return -log1pf(expf(-x));
}
DI float row_rstd(const float* ssq, int row) {
  const f32x4* q = (const f32x4*)(ssq + (size_t)row * 32);
  f32x4 a[8];
#pragma unroll
  for (int i = 0; i < 8; ++i) a[i] = q[i];
  float s = 0.f;
#pragma unroll
  for (int i = 0; i < 8; ++i) s += (a[i].x + a[i].y) + (a[i].z + a[i].w);
  return rsqrtf(s * (1.f / DM) + EPS);
}


#define XB_TMO      128
#define XB_XCNT(j)  (256  + 64 * (j))
#define XB_XSUB(j)  (1280 + 64 * (j))
#define XB_XGEN(j)  (2304 + 64 * (j))
#define XB_TOP      3328
#define XB_TOPGEN   3392
#define XCD_BAR_WORDS 3456
#define XB_SPIN_CAP (1u << 18)
#define LAS __attribute__((address_space(3)))
DI unsigned xb_ld(unsigned* p) { return __hip_atomic_load(p, __ATOMIC_RELAXED, __HIP_MEMORY_SCOPE_AGENT); }
DI unsigned xb_add(unsigned* p, unsigned v) { return __hip_atomic_fetch_add(p, v, __ATOMIC_RELAXED, __HIP_MEMORY_SCOPE_AGENT); }
DI unsigned xb_xcc_id() { return (unsigned)__builtin_amdgcn_s_getreg((3 << 11) | 20) & 0xFu; }
#define XB_SPIN(cond, bar) do { unsigned _sp = 0; while (cond) { __builtin_amdgcn_s_sleep(1); \
    if ((++_sp & 255u) == 0u) { if (xb_ld(&(bar)[XB_TMO])) break; if (_sp > XB_SPIN_CAP) { atomicAdd(&(bar)[XB_TMO], 1u); break; } } } } while (0)
struct XcdBarrier { unsigned* bar; unsigned x; volatile LAS unsigned* st; };
DI XcdBarrier xcd_barrier_post(unsigned* bar, volatile LAS unsigned* st) {
  XcdBarrier b; b.bar = bar; b.x = xb_xcc_id(); b.st = st;
  if (threadIdx.x == 0) (void)xb_add(&bar[XB_XCNT(b.x)], 1u);
  return b;
}
DI void xcd_barrier_complete(unsigned* bar, unsigned x, unsigned& nloc, unsigned& nx) {
  const unsigned G = gridDim.x * gridDim.y * gridDim.z;
  unsigned sum, cnt, mine, sp = 0u;
  for (;;) {
    sum = 0u; cnt = 0u; mine = 0u;
#pragma unroll
    for (unsigned j = 0; j < 16; ++j) { const unsigned c = xb_ld(&bar[XB_XCNT(j)]); sum += c; cnt += (c > 0u) ? 1u : 0u; mine = (j == x) ? c : mine; }
    if (sum == G) break;
    __builtin_amdgcn_s_sleep(1);
    if ((++sp & 255u) == 0u) { if (xb_ld(&bar[XB_TMO])) break; if (sp > XB_SPIN_CAP) { atomicAdd(&bar[XB_TMO], 1u); break; } }
  }
  nloc = mine > 0u ? mine : 1u; nx = cnt > 0u ? cnt : 1u;
}
DI void xcd_barrier(const XcdBarrier& b) {
  asm volatile("s_waitcnt vmcnt(0)" ::: "memory");
  __syncthreads();
  if (threadIdx.x == 0) {
    unsigned* bar = b.bar;
    __builtin_amdgcn_s_waitcnt(0);
    unsigned nloc = b.st[0], nx = b.st[1];
    if (nloc == 0u) { xcd_barrier_complete(bar, b.x, nloc, nx); b.st[0] = nloc; b.st[1] = nx; }
    const unsigned old = xb_add(&bar[XB_XSUB(b.x)], 1u);
    const unsigned gen = old / nloc;
    if (old + 1u == (gen + 1u) * nloc) {
      __builtin_amdgcn_fence(__ATOMIC_RELEASE, "agent");
      asm volatile("s_waitcnt vmcnt(0)" ::: "memory");
      const unsigned og = xb_add(&bar[XB_TOP], 1u);
      const unsigned tg = og / nx;
      if (og + 1u == (tg + 1u) * nx) xb_add(&bar[XB_TOPGEN], 1u);
      else XB_SPIN(xb_ld(&bar[XB_TOPGEN]) == tg, bar);
      __builtin_amdgcn_fence(__ATOMIC_ACQUIRE, "agent");
      xb_add(&bar[XB_XGEN(b.x)], 1u);
      asm volatile("s_waitcnt vmcnt(0)" ::: "memory");
    } else {
      XB_SPIN(xb_ld(&bar[XB_XGEN(b.x)]) == gen, bar);
      __builtin_amdgcn_fence(__ATOMIC_ACQUIRE, "agent");
      asm volatile("s_waitcnt vmcnt(0)" ::: "memory");
    }
  }
  __syncthreads();
}

struct TileDesc { const float* src; bf16_t* dst; int N, K, k0, n0, mode; };
DI TileDesc big_tile(const Params& p, int l, int v) {
  TileDesc d;
  if (v < 704) { d.src = p.w_in + (size_t)l * 1024 * INC; d.dst = p.wt_in + (size_t)l * INC * 1024; d.N = INC; d.K = 1024; d.k0 = (v / 44) * 64; d.n0 = (v % 44) * 64; d.mode = 0; }
  else if ((v -= 704) < 256) { d.src = p.w_out + (size_t)l * 1024 * 1024; d.dst = p.wt_out + (size_t)l * 1024 * 1024; d.N = 1024; d.K = 1024; d.k0 = (v / 16) * 64; d.n0 = (v % 16) * 64; d.mode = 0; }
  else if ((v -= 256) < 1408) { d.src = p.w_ffn_in + (size_t)l * 1024 * 5632; d.dst = p.wt_ffi + (size_t)l * 5632 * 1024; d.N = 5632; d.K = 1024; d.k0 = (v / 88) * 64; d.n0 = (v % 88) * 64; d.mode = 1; }
  else { v -= 1408; d.src = p.w_ffn_out + (size_t)l * DFF * 1024; d.dst = p.wt_ffo + (size_t)l * 1024 * DFF; d.N = 1024; d.K = DFF; d.k0 = (v / 16) * 64; d.n0 = (v % 16) * 64; d.mode = 0; }
  return d;
}
DI TileDesc small_tile(const Params& p, int l, int v) {
  TileDesc d;
  if (v < 16) { d.src = p.conv_pw + (size_t)l * 65536; d.dst = p.wt_pw + (size_t)l * 65536; d.N = 256; d.K = 256; d.k0 = (v / 4) * 64; d.n0 = (v % 4) * 64; d.mode = 0; }
  else { v -= 16; d.src = p.pool_w + (size_t)(l * 4 + v) * 4096; d.dst = p.wt_pool + (size_t)(l * 4 + v) * 4096; d.N = 64; d.K = 64; d.k0 = 0; d.n0 = 0; d.mode = 0; }
  return d;
}
DI void tile_load(const TileDesc& d, int tid, f32x4 (&r)[4]) {
#pragma unroll
  for (int i = 0; i < 4; ++i) r[i] = *(const f32x4*)(d.src + (size_t)(d.k0 + i * 16 + (tid >> 4)) * d.N + d.n0 + (tid & 15) * 4);
}
DI void tile_to_lds(int tid, const f32x4 (&r)[4], float* tile) {
#pragma unroll
  for (int i = 0; i < 4; ++i) {
    int rr = i * 16 + (tid >> 4), c4 = (tid & 15) * 4;
    tile[rr * 65 + c4 + 0] = r[i].x; tile[rr * 65 + c4 + 1] = r[i].y; tile[rr * 65 + c4 + 2] = r[i].z; tile[rr * 65 + c4 + 3] = r[i].w;
  }
}
DI void tile_store(const TileDesc& d, int tid, const float* tile) {
#pragma unroll
  for (int i = 0; i < 2; ++i) {
    int q = tid + 256 * i, nl = q >> 3, kc = q & 7;
    float f[8];
#pragma unroll
    for (int j = 0; j < 8; ++j) f[j] = tile[(kc * 8 + j) * 65 + nl];
    u32x4 o;
    o.x = pack2(f[0], f[1]); o.y = pack2(f[2], f[3]); o.z = pack2(f[4], f[5]); o.w = pack2(f[6], f[7]);
    int n = d.n0 + nl, np = n;
    if (d.mode == 1) {
      if (n < DFF) np = 256 * (n >> 7) + (n & 127);
      else { int n2 = n - DFF; np = 256 * (n2 >> 7) + 128 + (n2 & 127); }
    }
    *(u32x4*)(d.dst + (size_t)np * d.K + d.k0 + kc * 8) = o;
  }
}
template <class Decode>
DI void transpose_run(int first, int n, int stride, const Decode& dec, char* lds) {
  const int tid = opaque_tid();
  float* tile = (float*)lds;
  int t = first;
  TileDesc d, dn;
  f32x4 cur[4], nxt[4];
  if (t < n) { d = dec(t); tile_load(d, tid, cur); }
  while (t < n) {
    tile_to_lds(tid, cur, tile);
    lds_barrier();
    const int tn = t + stride;
    dn = d;
    if (tn < n) { dn = dec(tn); tile_load(dn, tid, nxt); }
    tile_store(d, tid, tile);
    lds_barrier();
    d = dn;
#pragma unroll
    for (int i = 0; i < 4; ++i) cur[i] = nxt[i];
    t = tn;
  }
}

DI void gemv5_task(const float* S, const float* W, int N, int n0, const float* bias, float* out, float* red) {
  const int tid = opaque_tid(), c4 = (tid & 7) * 4, ks = tid >> 3;
  f32x4 a[5];
#pragma unroll
  for (int r = 0; r < 5; ++r) a[r] = f32x4{0.f, 0.f, 0.f, 0.f};
  const float* wp = W + (size_t)(ks * 32) * N + n0 + c4;
  const float* sp = S + ks * 32;
  {
    constexpr int kb = 0;
    f32x4 w[32];
#pragma unroll
    for (int k = 0; k < 32; ++k) w[k] = *(const f32x4*)(wp + (size_t)(kb + k) * N);
#pragma unroll
    for (int k = 0; k < 32; ++k)
#pragma unroll
      for (int r = 0; r < 5; ++r) a[r] += w[k] * sp[r * 1024 + kb + k];
  }
#pragma unroll
  for (int r = 0; r < 5; ++r) *(f32x4*)(red + (ks * 5 + r) * 32 + c4) = a[r];
  lds_barrier();
  if (tid < 160) {
    int r = tid >> 5, cn = tid & 31;
    float s = bias ? bias[n0 + cn] : 0.f;
#pragma unroll 8
    for (int q = 0; q < 32; ++q) s += red[(q * 5 + r) * 32 + cn];
    out[(size_t)r * N + n0 + cn] = s;
  }
  lds_barrier();
}

DI void bias_task(const Params& p, int l, int which  , int blk) {
  const int tid = opaque_tid(), wid = tid >> 6, lane = tid & 63;
  const float* sb = p.mod + (size_t)l * 5 * 6144 + (which ? 3072 : 0) + lane * 16;
  f32x4 s[5][4];
#pragma unroll
  for (int r = 0; r < 5; ++r)
#pragma unroll
    for (int i = 0; i < 4; ++i) s[r][i] = *(const f32x4*)(sb + (size_t)r * 6144 + 4 * i);
  const bf16_t* wt = which ? p.wt_ffi + (size_t)l * 5632 * 1024 : p.wt_in + (size_t)l * INC * 1024;
  u32x4 wraw[8][2];
#pragma unroll
  for (int c = 0; c < 8; ++c) {
    const bf16_t* wp = wt + (size_t)(blk * 32 + wid * 8 + c) * 1024 + lane * 16;
    wraw[c][0] = *(const u32x4*)wp; wraw[c][1] = *(const u32x4*)(wp + 8);
  }
  float acc[8][5];
#pragma unroll
  for (int c = 0; c < 8; ++c) {
    const u32x4 w0 = wraw[c][0], w1 = wraw[c][1];
    f32x4 wf[4];
    wf[0] = f32x4{__uint_as_float(w0.x << 16), __uint_as_float(w0.x & 0xffff0000u), __uint_as_float(w0.y << 16), __uint_as_float(w0.y & 0xffff0000u)};
    wf[1] = f32x4{__uint_as_float(w0.z << 16), __uint_as_float(w0.z & 0xffff0000u), __uint_as_float(w0.w << 16), __uint_as_float(w0.w & 0xffff0000u)};
    wf[2] = f32x4{__uint_as_float(w1.x << 16), __uint_as_float(w1.x & 0xffff0000u), __uint_as_float(w1.y << 16), __uint_as_float(w1.y & 0xffff0000u)};
    wf[3] = f32x4{__uint_as_float(w1.z << 16), __uint_as_float(w1.z & 0xffff0000u), __uint_as_float(w1.w << 16), __uint_as_float(w1.w & 0xffff0000u)};
#pragma unroll
    for (int r = 0; r < 5; ++r) {
      f32x4 t = s[r][0] * wf[0] + s[r][1] * wf[1] + s[r][2] * wf[2] + s[r][3] * wf[3];
      acc[c][r] = (t.x + t.y) + (t.z + t.w);
    }
  }
#pragma unroll
  for (int of = 32; of >= 1; of >>= 1) {
    float t[8][5];
#pragma unroll
    for (int c = 0; c < 8; ++c)
#pragma unroll
      for (int r = 0; r < 5; ++r) t[c][r] = __shfl_xor(acc[c][r], of);
#pragma unroll
    for (int c = 0; c < 8; ++c)
#pragma unroll
      for (int r = 0; r < 5; ++r) acc[c][r] += t[c][r];
  }
  if (lane == 0) {
#pragma unroll
    for (int c = 0; c < 8; ++c) {
      const int np = blk * 32 + wid * 8 + c;
      if (which == 0) {
#pragma unroll
        for (int r = 0; r < 5; ++r) p.biasIn[(size_t)(l * 5 + r) * INC + np] = acc[c][r];
      } else {
        const int q = np >> 8, rr = np & 255;
        const int col = rr < 128 ? 128 * q + rr : DFF + 128 * q + rr - 128;
#pragma unroll
        for (int r = 0; r < 5; ++r) p.biasFf[(size_t)(l * 5 + r) * 5632 + col] = acc[c][r];
      }
    }
  }
}
DI void bias_tasks(const Params& p, int l, int first, int stride) {
  for (int t = first; t < 264; t += stride) {
    if (t < 88) bias_task(p, l, 0, t);
    else bias_task(p, l, 1, t - 88);
  }
}

struct DecPrep0 { const Params* p; DI TileDesc operator()(int t) const { return t < 704 ? big_tile(*p, 0, t) : (t < 724 ? small_tile(*p, 0, t - 704) : small_tile(*p, 1, t - 724)); } };
struct DecRest { const Params* p; int l; DI TileDesc operator()(int t) const { return big_tile(*p, l, 704 + t); } };
struct DecIn1 { const Params* p; DI TileDesc operator()(int t) const { return big_tile(*p, 1, t); } };

DI void phase_prep0(const Params& p, char* lds, int vbi, int nvb) {
  const int tid = opaque_tid();
  float* S = (float*)lds;
  float* red = (float*)(lds + 20480);
  constexpr int NGEMV = 2 * 192;
  if (vbi < NGEMV) {
    float cv[20];
#pragma unroll
    for (int j = 0; j < 20; ++j) {
      const int i = tid + 256 * j, r = i >> 10, k = i & 1023;
      cv[j] = r == 0 ? p.c_ctx[k] : p.c[(r - 1) * 1024 + k];
    }
#pragma unroll
    for (int j = 0; j < 20; ++j) S[tid + 256 * j] = silu_f(cv[j]);
    lds_barrier();
    for (int t = vbi; t < NGEMV; t += nvb) {
      int l = t / 192, nb = t % 192;
      gemv5_task(S, p.w_ada + (size_t)l * 1024 * 6144, 6144, nb * 32, p.b_ada + l * 6144, p.mod + (size_t)l * 5 * 6144, red);
    }
  } else if (vbi == NGEMV) {
    for (int i = tid; i < 1024; i += 256) {
      int pos = i >> 4, f = i & 15;
      float inv = exp2f(-(float)f * (1.f / 16.f) * 13.287712379549449f);
      float ang = (float)pos * inv;
      p.rope[2 * i] = cosf(ang);
      p.rope[2 * i + 1] = sinf(ang);
    }
  }
  DecPrep0 dec{&p};
  transpose_run((vbi + nvb - (NGEMV & ~1)) % nvb, 744, nvb, dec, lds);
}

DI void phase_prep1(const Params& p, char* lds, int vbi, int nvb) {
  const int tid = opaque_tid(), wid = tid >> 6, lane = tid & 63;
  constexpr int NB = 88;
  constexpr int NG = 80;
  constexpr int NXG = NTOK / 16;
  const int ntask = NB + NG + NXG;
  for (int t = vbi; t < ntask; t += nvb) {
    if (t < NB) {
      bias_task(p, 0, 0, t);
    } else if (t < NB + NG) {
      int i = (t - NB) * 256 + tid;
      int which = i / 10240, rem = i % 10240, l = rem / 5120, r = (rem % 5120) >> 10, k = rem & 1023;
      if (which == 0) p.G1[(l * 5 + r) * 1024 + k] = p.g_norm1[l * 1024 + k] * (1.f + p.mod[(size_t)(l * 5 + r) * 6144 + 1024 + k]);
      else p.G2[(l * 5 + r) * 1024 + k] = p.g_norm2[l * 1024 + k] * (1.f + p.mod[(size_t)(l * 5 + r) * 6144 + 4096 + k]);
    } else {
      int rb = (t - NB - NG) * 16 + wid * 4;
      for (int rr = 0; rr < 4; ++rr) {
        int T = rb + rr, ss, L, mr;
        tokinfo(T, ss, L, mr);
        const float* xr = xin_row(p, T);
        const float* mrow = p.mod + (size_t)mr * 6144 + 1024;
        float sq = 0.f;
        f32x4 xv[4], gv[4], scv[4];
#pragma unroll
        for (int i = 0; i < 4; ++i) {
          int k = i * 256 + lane * 4;
          xv[i] = *(const f32x4*)(xr + k); gv[i] = *(const f32x4*)(p.g_norm1 + k); scv[i] = *(const f32x4*)(mrow + k);
        }

#pragma unroll
        for (int i = 0; i < 4; ++i) {
          int k = i * 256 + lane * 4;
          f32x4 v = xv[i], g = gv[i], sc = scv[i];
          sq += v.x * v.x + v.y * v.y + v.z * v.z + v.w * v.w;
          u32x2 o;
          o.x = pack2(v.x * g.x * (1.f + sc.x), v.y * g.y * (1.f + sc.y));
          o.y = pack2(v.z * g.z * (1.f + sc.z), v.w * g.w * (1.f + sc.w));
          *(u32x2*)(p.xg + (size_t)T * DM + k) = o;
        }
#pragma unroll
        for (int o = 32; o >= 1; o >>= 1) sq += __shfl_xor(sq, o);
        if (lane < 32) p.ssq[(size_t)T * 32 + lane] = lane == 0 ? sq : 0.f;
      }
    }
  }
}

namespace pg8 {
constexpr int BM = 256, BK = 64, HALF = 128, HTB = HALF * BK * 2, STAGE_BYTES = 8 * HTB, NXCD = 8, WGM = 8;
DI int lds_byte(int r, int c) { const int st = (r >> 4) * 2 + (c >> 5), rr = r & 15, cc = c & 31, ob = rr * 64 + cc * 2; return st * 1024 + (ob ^ (((ob >> 9) & 1) << 5)); }
DI int perm32(int rho) { const int n = rho >> 4, i = rho & 15; return 8 * (i >> 2) + 4 * n + (i & 3); }
DI void stage_rc(int b, int& R, int& C) { const int st = b / 1024, sb = b % 1024, swz = sb ^ (((sb >> 9) & 1) << 5); R = (st >> 1) * 16 + swz / 64; C = (st & 1) * 32 + (swz % 64) / 2; }
struct Unit { int pm, pn, idx; };
struct Gemm { const bf16_t* A; const bf16_t* Bt; int M, N, K; };
struct StaticOrder {
  int nM, nN, nwg, G, c, wgm;
  DI void init(int M, int N, int tn, int G_, int c_, int wgm_ = WGM) { nM = M / BM; nN = N / tn; nwg = nM * nN; G = G_; c = c_; wgm = wgm_; }
  DI bool next(int i, Unit& u) const {
    const long L = (long)i * G + c; if (L >= nwg) return false;
    int wgid = (int)L; { const int q = nwg / NXCD, r = nwg % NXCD, xcd = wgid % NXCD, off = wgid / NXCD; wgid = (xcd < r ? xcd * (q + 1) : r * (q + 1) + (xcd - r) * q) + off; }
    const int nig = wgm * nN, gid = wgid / nig, fm = gid * wgm, gsz = (nM - fm) < wgm ? (nM - fm) : wgm;
    u.pm = fm + ((wgid % nig) % gsz); u.pn = (wgid % nig) / gsz; return true;
  }
};
DI unsigned cvt_pk_bf16(float lo, float hi) { unsigned r; asm volatile("v_cvt_pk_bf16_f32 %0, %1, %2" : "=v"(r) : "v"(lo), "v"(hi)); return r; }

template <int NH, class Epi>
DI void gemm_phase(LAS unsigned char* lds, const Gemm g, const StaticOrder& S, const Epi& E) {
  int tid = threadIdx.x; asm volatile("" : "+v"(tid));
  const int wid = __builtin_amdgcn_readfirstlane(tid >> 6), lane = tid & 63, wr = wid >> 2, wc = wid & 3, fr = lane & 15, fq = lane >> 4;
  const int K = g.K, nt = K / BK;
  unsigned voffA[2], voffB[2];
#pragma unroll
  for (int i = 0; i < 2; ++i) { int R, C; stage_rc(tid * 16 + i * 8192, R, C); voffA[i] = (unsigned)(R * K + C) * 2u; voffB[i] = (unsigned)(((R & ~31) + perm32(R & 31)) * K + C) * 2u; }
  const size_t kstep = (size_t)(BK * 2);
  const size_t hstep = (size_t)HALF * K * 2;
  const size_t tstep = 2 * hstep;
  const unsigned ldsw = (unsigned)wid * 1024u;
  const int aoff = lds_byte(wr * 64 + fr, fq * 8), boff = lds_byte(wc * 32 + fr, fq * 8);
  const unsigned ldsb = (unsigned)(size_t)lds;
#define PG8_SA(b, h) (((b) * 2 + (h)) * HTB)
#define PG8_SB(b, h) ((4 + (b) * 2 + (h)) * HTB)
#define PG8_STAGE(bufoff, gbase, voff) do { _Pragma("unroll") for (int _i = 0; _i < 2; ++_i) \
    __builtin_amdgcn_global_load_lds((const unsigned*)((const char*)(gbase) + (voff)[_i]), (LAS unsigned*)(lds + (bufoff) + ldsw + _i * 8192), 16, 0, 0); } while (0)
#define PG8_DSR(dst, addr, off) asm volatile("ds_read_b128 %0, %1 offset:" #off : "=v"(dst) : "v"(addr))
#define PG8_LDA(dst, b, h) do { const unsigned _a = ldsb + PG8_SA(b, h) + aoff; PG8_DSR(dst[0][0], _a, 0); PG8_DSR(dst[0][1], _a, 1024); PG8_DSR(dst[1][0], _a, 2048); PG8_DSR(dst[1][1], _a, 3072); \
    PG8_DSR(dst[2][0], _a, 4096); PG8_DSR(dst[2][1], _a, 5120); PG8_DSR(dst[3][0], _a, 6144); PG8_DSR(dst[3][1], _a, 7168); } while (0)
#define PG8_LDB(dst, b, h) do { const unsigned _a = ldsb + PG8_SB(b, h) + boff; PG8_DSR(dst[0][0], _a, 0); PG8_DSR(dst[0][1], _a, 1024); PG8_DSR(dst[1][0], _a, 2048); PG8_DSR(dst[1][1], _a, 3072); } while (0)
#define PG8_PIN_A(A) asm volatile("s_waitcnt lgkmcnt(0)" : "+v"(A[0][0]), "+v"(A[0][1]), "+v"(A[1][0]), "+v"(A[1][1]), "+v"(A[2][0]), "+v"(A[2][1]), "+v"(A[3][0]), "+v"(A[3][1]) :: "memory")
#define PG8_PIN_B(B) asm volatile("s_waitcnt lgkmcnt(0)" : "+v"(B[0][0]), "+v"(B[0][1]), "+v"(B[1][0]), "+v"(B[1][1]) :: "memory")
#define PG8_MMA(ai, bj, At, Bt) do { __builtin_amdgcn_s_setprio(1); _Pragma("unroll") for (int m = 0; m < 4; ++m) _Pragma("unroll") for (int n = 0; n < 2; ++n) _Pragma("unroll") for (int k = 0; k < 2; ++k) \
    acc[ai][bj][m][n] = __builtin_amdgcn_mfma_f32_16x16x32_bf16(Bt[n][k], At[m][k], acc[ai][bj][m][n], 0, 0, 0); __builtin_amdgcn_s_setprio(0); } while (0)
#define PG8_WAIT_V(n) asm volatile("s_waitcnt vmcnt(" #n ")" ::: "memory")
#define PG8_WAIT_L(n) asm volatile("s_waitcnt lgkmcnt(" #n ")" ::: "memory")
#define PG8_BAR __builtin_amdgcn_s_barrier()
#define PG8_SCHED __builtin_amdgcn_sched_barrier(0)
  Unit cur, nxt; int ui = 0;
  if (!S.next(0, cur)) return;
  cur.idx = 0;
  f32x4 acc[2][2][4][2];
#pragma unroll
  for (int a = 0; a < 2; ++a)
#pragma unroll
    for (int b = 0; b < 2; ++b)
#pragma unroll
      for (int m = 0; m < 4; ++m)
#pragma unroll
        for (int n = 0; n < 2; ++n) acc[a][b][m][n] = (f32x4){0.f, 0.f, 0.f, 0.f};
  bf16x8 At[4][2], B0[2][2], B1[2][2];
  const size_t bstep = NH * hstep;
  const char* cA = (const char*)g.A + (size_t)cur.pm * tstep; const char* cB = (const char*)g.Bt + (size_t)cur.pn * bstep;
  PG8_STAGE(PG8_SB(0, 0), cB, voffB); PG8_STAGE(PG8_SA(0, 0), cA, voffA); PG8_STAGE(PG8_SB(0, 1), cB + hstep, voffB); PG8_STAGE(PG8_SA(0, 1), cA + hstep, voffA);
  if (wr == 1) PG8_BAR;
  PG8_WAIT_V(4); PG8_BAR;
  PG8_STAGE(PG8_SB(1, 0), cB + kstep, voffB); PG8_STAGE(PG8_SA(1, 0), cA + kstep, voffA); PG8_STAGE(PG8_SB(1, 1), cB + hstep + kstep, voffB);
  PG8_WAIT_V(6); PG8_BAR;
  for (;;) {
    const bool has_next = S.next(ui + 1, nxt);
    nxt.idx = ui + 1;
    const char* nA = has_next ? (const char*)g.A + (size_t)nxt.pm * tstep : cA; const char* nB = has_next ? (const char*)g.Bt + (size_t)nxt.pn * bstep : cB;
    for (int t = 0; t < nt; t += 2) {
      const bool last = (t == nt - 2);
      const char* a1 = cA + (size_t)(t + 1) * kstep;
      const char* a2 = last ? nA : cA + (size_t)(t + 2) * kstep; const char* b2 = last ? nB : cB + (size_t)(t + 2) * kstep;
      const char* a3 = a2 + kstep; const char* b3 = b2 + kstep;
      PG8_LDB(B0, 0, 0); PG8_SCHED; PG8_LDA(At, 0, 0); PG8_STAGE(PG8_SA(1, 1), a1 + hstep, voffA);
      PG8_WAIT_L(8); PG8_BAR; PG8_PIN_A(At); PG8_PIN_B(B0); PG8_MMA(0, 0, At, B0); PG8_BAR; PG8_SCHED;
      PG8_LDB(B1, 0, 1); PG8_STAGE(PG8_SB(0, 0), b2, voffB);
      PG8_BAR; PG8_PIN_B(B1); PG8_MMA(0, 1, At, B1); PG8_BAR;
      PG8_LDA(At, 0, 1); PG8_STAGE(PG8_SA(0, 0), a2, voffA);
      PG8_BAR; PG8_PIN_A(At); PG8_MMA(1, 0, At, B0); PG8_BAR; PG8_SCHED;
      PG8_STAGE(PG8_SB(0, 1), b2 + hstep, voffB);
      PG8_WAIT_V(6); PG8_BAR; PG8_MMA(1, 1, At, B1); PG8_BAR;
      PG8_LDB(B0, 1, 0); PG8_SCHED; PG8_LDA(At, 1, 0); PG8_STAGE(PG8_SA(0, 1), a2 + hstep, voffA);
      PG8_WAIT_L(8); PG8_BAR; PG8_PIN_A(At); PG8_PIN_B(B0); PG8_MMA(0, 0, At, B0); PG8_BAR; PG8_SCHED;
      PG8_LDB(B1, 1, 1); PG8_STAGE(PG8_SB(1, 0), b3, voffB);
      PG8_BAR; PG8_PIN_B(B1); PG8_MMA(0, 1, At, B1); PG8_BAR;
      PG8_LDA(At, 1, 1); PG8_STAGE(PG8_SA(1, 0), a3, voffA);
      PG8_BAR; PG8_PIN_A(At); PG8_MMA(1, 0, At, B0); PG8_BAR; PG8_SCHED;
      PG8_STAGE(PG8_SB(1, 1), b3 + hstep, voffB);
      PG8_WAIT_V(6); PG8_BAR; PG8_MMA(1, 1, At, B1); PG8_BAR;
    }
    E(acc, cur, wr, wc, fr, fq);
    if (!has_next) break;
#pragma unroll
    for (int a = 0; a < 2; ++a)
#pragma unroll
      for (int b = 0; b < 2; ++b)
#pragma unroll
        for (int m = 0; m < 4; ++m)
#pragma unroll
          for (int n = 0; n < 2; ++n) acc[a][b][m][n] = (f32x4){0.f, 0.f, 0.f, 0.f};
    cur = nxt; cA = nA; cB = nB; ++ui;
  }
  PG8_WAIT_V(0);
  if (wr == 0) PG8_BAR;
  PG8_BAR;
#undef PG8_SA
#undef PG8_SB
#undef PG8_STAGE
#undef PG8_LDA
#undef PG8_LDB
#undef PG8_PIN_A
#undef PG8_PIN_B
#undef PG8_MMA
#undef PG8_WAIT_V
#undef PG8_WAIT_L
#undef PG8_BAR
#undef PG8_SCHED
}

template <class Pre, class Epi>
DI void gemm_phase_n128(LAS unsigned char* lds, const Gemm g, const StaticOrder& S, const Epi& E) {
  int tid = threadIdx.x; asm volatile("" : "+v"(tid));
  const int wid = __builtin_amdgcn_readfirstlane(tid >> 6), lane = tid & 63, wr = wid >> 2, wc = wid & 3, fr = lane & 15, fq = lane >> 4;
  const int K = g.K, nt = K / BK;
  unsigned voff[2], voffB[2];
#pragma unroll
  for (int i = 0; i < 2; ++i) { int R, C; stage_rc(tid * 16 + i * 8192, R, C); voff[i] = (unsigned)(R * K + C) * 2u; voffB[i] = (unsigned)(((R & ~31) + perm32(R & 31)) * K + C) * 2u; }
  const size_t kstep = (size_t)(BK * 2);
  const size_t hstep = (size_t)HALF * K * 2;
  const unsigned ldsw = (unsigned)wid * 1024u;
  const int aoff = lds_byte(wr * 64 + fr, fq * 8), boff = lds_byte(wc * 32 + fr, fq * 8);
  constexpr int BUF = 3 * HTB;
  const unsigned ldsb = (unsigned)(size_t)lds;
#define N1_STG(bufoff, gbase, vo) do { _Pragma("unroll") for (int _i = 0; _i < 2; ++_i) \
    __builtin_amdgcn_global_load_lds((const unsigned*)((const char*)(gbase) + (vo)[_i]), (LAS unsigned*)(lds + (bufoff) + ldsw + _i * 8192), 16, 0, 0); } while (0)
#define N1_STAGE3(q, kt) do { const size_t _ko = (size_t)(kt) * kstep; N1_STG((q) * BUF, cB + _ko, voffB); N1_STG((q) * BUF + HTB, cA + _ko, voff); N1_STG((q) * BUF + 2 * HTB, cA + hstep + _ko, voff); } while (0)
#define N1_LDA(dst, q, h) do { const unsigned _a = ldsb + (q) * BUF + (1 + (h)) * HTB + aoff; PG8_DSR(dst[0][0], _a, 0); PG8_DSR(dst[0][1], _a, 1024); PG8_DSR(dst[1][0], _a, 2048); PG8_DSR(dst[1][1], _a, 3072); \
    PG8_DSR(dst[2][0], _a, 4096); PG8_DSR(dst[2][1], _a, 5120); PG8_DSR(dst[3][0], _a, 6144); PG8_DSR(dst[3][1], _a, 7168); } while (0)
#define N1_LDB(dst, q) do { const unsigned _a = ldsb + (q) * BUF + boff; PG8_DSR(dst[0][0], _a, 0); PG8_DSR(dst[0][1], _a, 1024); PG8_DSR(dst[1][0], _a, 2048); PG8_DSR(dst[1][1], _a, 3072); } while (0)
#define N1_LDAH(dst, q, h, m0) do { const unsigned _a = ldsb + (q) * BUF + (1 + (h)) * HTB + aoff + (m0) * 2048; PG8_DSR(dst[m0][0], _a, 0); PG8_DSR(dst[m0][1], _a, 1024); PG8_DSR(dst[m0 + 1][0], _a, 2048); PG8_DSR(dst[m0 + 1][1], _a, 3072); } while (0)
#define N1_PIN(Bf) asm volatile("s_waitcnt lgkmcnt(0)" : "+v"(A0[0][0]), "+v"(A0[0][1]), "+v"(A0[1][0]), "+v"(A0[1][1]), "+v"(A0[2][0]), "+v"(A0[2][1]), "+v"(A0[3][0]), "+v"(A0[3][1]), \
    "+v"(A1[0][0]), "+v"(A1[0][1]), "+v"(A1[1][0]), "+v"(A1[1][1]), "+v"(A1[2][0]), "+v"(A1[2][1]), "+v"(A1[3][0]), "+v"(A1[3][1]), "+v"(Bf[0][0]), "+v"(Bf[0][1]), "+v"(Bf[1][0]), "+v"(Bf[1][1]) :: "memory")
#define N1_MMAQ(ai, At, m0, Bf) do { __builtin_amdgcn_s_setprio(1); _Pragma("unroll") for (int m = m0; m < m0 + 2; ++m) _Pragma("unroll") for (int n = 0; n < 2; ++n) _Pragma("unroll") for (int k = 0; k < 2; ++k) \
    acc[ai][0][m][n] = __builtin_amdgcn_mfma_f32_16x16x32_bf16(Bf[n][k], At[m][k], acc[ai][0][m][n], 0, 0, 0); __builtin_amdgcn_s_setprio(0); } while (0)
  Unit cur;
  for (int ui = 0; S.next(ui, cur); ++ui) {
    cur.idx = ui;
    f32x4 acc[2][2][4][2];
#pragma unroll
    for (int a = 0; a < 2; ++a)
#pragma unroll
      for (int m = 0; m < 4; ++m)
#pragma unroll
        for (int n = 0; n < 2; ++n) acc[a][0][m][n] = (f32x4){0.f, 0.f, 0.f, 0.f};
    Pre P;
    E.pre(cur, wr, wc, fr, fq, P);
    const char* cA = (const char*)g.A + (size_t)cur.pm * 2 * hstep; const char* cB = (const char*)g.Bt + (size_t)cur.pn * hstep;
    N1_STAGE3(0, 0); N1_STAGE3(1, 1); N1_STAGE3(2, 2 < nt ? 2 : 0);
    asm volatile("s_waitcnt vmcnt(12)" ::: "memory");
    __builtin_amdgcn_s_barrier(); asm volatile("" ::: "memory");
    bf16x8 A0[4][2], A1[4][2], BfA[2][2], BfB[2][2];
    N1_LDB(BfA, 0); N1_LDA(A0, 0, 0); N1_LDA(A1, 0, 1);
    int cb = 0, rb = 1;
#define N1_SCHED __builtin_amdgcn_sched_barrier(0)
#define N1_ITER(Bc, Bn) do { \
      asm volatile("s_waitcnt vmcnt(6)" ::: "memory"); \
      N1_PIN(Bc); \
      __builtin_amdgcn_s_barrier(); asm volatile("" ::: "memory"); \
      const int ts = (t + 3 < nt) ? t + 3 : 0; \
      const size_t ko = (size_t)ts * kstep; \
      N1_LDB(Bn, rb); N1_SCHED; \
      N1_MMAQ(0, A0, 0, Bc); N1_SCHED; N1_STG(cb * BUF, cB + ko, voffB); N1_LDAH(A0, rb, 0, 0); N1_SCHED; \
      N1_MMAQ(0, A0, 2, Bc); N1_SCHED; N1_STG(cb * BUF + HTB, cA + ko, voff); N1_LDAH(A0, rb, 0, 2); N1_SCHED; \
      N1_MMAQ(1, A1, 0, Bc); N1_SCHED; N1_STG(cb * BUF + 2 * HTB, cA + hstep + ko, voff); N1_LDAH(A1, rb, 1, 0); N1_SCHED; \
      N1_MMAQ(1, A1, 2, Bc); N1_SCHED; \
      N1_LDAH(A1, rb, 1, 2); \
      cb = rb; rb = rb == 2 ? 0 : rb + 1; ++t; } while (0)
    for (int t = 0; t < nt;) {
      N1_ITER(BfA, BfB);
      N1_ITER(BfB, BfA);
    }
#undef N1_ITER
#undef N1_SCHED
    asm volatile("s_waitcnt vmcnt(0) lgkmcnt(0)" ::: "memory");
    __builtin_amdgcn_s_barrier(); asm volatile("" ::: "memory");
    E(acc, cur, wr, wc, fr, fq, P);
  }
#undef N1_STG
#undef N1_STAGE3
#undef N1_LDA
#undef N1_LDB
#undef N1_PIN
#undef N1_LDAH
#undef N1_MMAQ
#undef PG8_DSR
}
}

DI void rows_rstd(const float* ssq, int row0, int fq, float (&rs)[2][4]) {
  f32x4 pv[2][4][2];
#pragma unroll
  for (int ai = 0; ai < 2; ++ai)
#pragma unroll
    for (int m = 0; m < 4; ++m) {
      const f32x4* q = (const f32x4*)(ssq + (size_t)(row0 + ai * 128 + m * 16) * 32 + 8 * fq);
      pv[ai][m][0] = q[0]; pv[ai][m][1] = q[1];
    }
#pragma unroll
  for (int ai = 0; ai < 2; ++ai)
#pragma unroll
    for (int m = 0; m < 4; ++m) {
      float s = ((pv[ai][m][0].x + pv[ai][m][0].y) + (pv[ai][m][0].z + pv[ai][m][0].w)) + ((pv[ai][m][1].x + pv[ai][m][1].y) + (pv[ai][m][1].z + pv[ai][m][1].w));
      s += __shfl_xor(s, 16); s += __shfl_xor(s, 32);
      rs[ai][m] = rsqrtf(s * (1.f / DM) + EPS);
    }
}
constexpr int EPI_MAXU = 7;
#define EPI_DSR32(dst, addr, off) asm volatile("ds_read_b32 %0, %1 offset:" #off : "=v"(dst) : "v"(addr))
#define EPI_DSR128(dst, addr, off) asm volatile("ds_read_b128 %0, %1 offset:" #off : "=v"(dst) : "v"(addr))
DI void epi_read(unsigned rs_addr, unsigned b_addr, float (&rs)[2][4], f32x4 (&bv)[4]) {
  EPI_DSR32(rs[0][0], rs_addr, 0); EPI_DSR32(rs[0][1], rs_addr, 64); EPI_DSR32(rs[0][2], rs_addr, 128); EPI_DSR32(rs[0][3], rs_addr, 192);
  EPI_DSR32(rs[1][0], rs_addr, 512); EPI_DSR32(rs[1][1], rs_addr, 576); EPI_DSR32(rs[1][2], rs_addr, 640); EPI_DSR32(rs[1][3], rs_addr, 704);
  EPI_DSR128(bv[0], b_addr, 0); EPI_DSR128(bv[1], b_addr, 16); EPI_DSR128(bv[2], b_addr, 512); EPI_DSR128(bv[3], b_addr, 528);
  asm volatile("s_waitcnt lgkmcnt(0)" : "+v"(rs[0][0]), "+v"(rs[0][1]), "+v"(rs[0][2]), "+v"(rs[0][3]), "+v"(rs[1][0]), "+v"(rs[1][1]), "+v"(rs[1][2]), "+v"(rs[1][3]),
               "+v"(bv[0]), "+v"(bv[1]), "+v"(bv[2]), "+v"(bv[3]) :: "memory");
}
DI void epi_tables(char* tab, const pg8::StaticOrder& S, const float* ssq, const float* bias, bool ffi) {
  float* t = (float*)tab;
  int tid = threadIdx.x; asm volatile("" : "+v"(tid));
  for (int i = 0; i < EPI_MAXU; ++i) {
    pg8::Unit u;
    if (!S.next(i, u)) break;
    if (tid < 256) t[i * 256 + tid] = row_rstd(ssq, u.pm * 256 + tid);
    else {
      const int c = tid - 256;
      int ss, L, mr;
      tokinfo(u.pm * 256, ss, L, mr);
      t[EPI_MAXU * 256 + i * 256 + c] = ffi ? bias[(size_t)mr * 5632 + (c < 128 ? 128 * u.pn + c : DFF + 128 * u.pn + c - 128)] : bias[(size_t)mr * INC + u.pn * 256 + c];
    }
  }
  __syncthreads();
}
struct EpiIn {
  bf16_t* proj; unsigned tab;
  DI void operator()(const f32x4 (&acc)[2][2][4][2], const pg8::Unit& u, int wr, int wc, int fr, int fq) const {
    const int row0 = u.pm * 256 + wr * 64 + fr, col0 = u.pn * 256 + wc * 32 + 8 * fq;
    const int ui = u.idx < EPI_MAXU ? u.idx : EPI_MAXU - 1;
    float rs[2][4];
    f32x4 bv[4];
    epi_read(tab + (ui * 256 + wr * 64 + fr) * 4, tab + (EPI_MAXU * 256 + ui * 256 + wc * 32 + 8 * fq) * 4, rs, bv);
#pragma unroll
    for (int ai = 0; ai < 2; ++ai)
#pragma unroll
      for (int m = 0; m < 4; ++m) {
        const int row = row0 + ai * 128 + m * 16;
        bf16_t* rowp = proj + (size_t)row * INC + col0;
#pragma unroll
        for (int bj = 0; bj < 2; ++bj) {
          const f32x4 v0 = acc[ai][bj][m][0] * rs[ai][m] + bv[bj * 2], v1 = acc[ai][bj][m][1] * rs[ai][m] + bv[bj * 2 + 1];
          u32x4 w; w.x = pack2(v0[0], v0[1]); w.y = pack2(v0[2], v0[3]); w.z = pack2(v1[0], v1[1]); w.w = pack2(v1[2], v1[3]);
          *(u32x4*)(rowp + bj * 128) = w;
        }
      }
  }
};
struct ResPre { f32x4 gav[2], xo[4][2]; };
struct EpiRes {
  const float* xold; const float *x_prompt, *x_sample; float* xres; bf16_t* xg; float* ssq; const float* ga; const float* Gn;
  DI void pre(const pg8::Unit& u, int wr, int wc, int fr, int fq, ResPre& P) const {
    const int row0 = u.pm * 256 + wr * 64 + fr, col0 = u.pn * 128 + wc * 32 + 8 * fq;
    int ss, L, mr;
    tokinfo(u.pm * 256, ss, L, mr);
#pragma unroll
    for (int n = 0; n < 2; ++n) {
      P.gav[n] = *(const f32x4*)(ga + (size_t)mr * 6144 + col0 + n * 4);
    }
#pragma unroll
    for (int m = 0; m < 4; ++m) {
      const int row = row0 + m * 16;
      const float* xp = xold ? xold + (size_t)row * DM : (row < NCTX ? x_prompt + (size_t)row * DM : x_sample + (size_t)(row - NCTX) * DM);
#pragma unroll
      for (int n = 0; n < 2; ++n) P.xo[m][n] = *(const f32x4*)(xp + col0 + n * 4);
    }
  }
  DI void operator()(const f32x4 (&acc)[2][2][4][2], const pg8::Unit& u, int wr, int wc, int fr, int fq, const ResPre& P) const {
    const int row0 = u.pm * 256 + wr * 64 + fr, col0 = u.pn * 128 + wc * 32 + 8 * fq;
    f32x4 xo1[4][2];
    f32x4 Gv[2];
    {
      int ss, L, mr;
      tokinfo(u.pm * 256, ss, L, mr);
#pragma unroll
      for (int n = 0; n < 2; ++n) Gv[n] = Gn ? *(const f32x4*)(Gn + mr * 1024 + col0 + n * 4) : (f32x4){0.f, 0.f, 0.f, 0.f};
    }
#pragma unroll
    for (int m = 0; m < 4; ++m) {
      const int row = row0 + 128 + m * 16;
      const float* xp = xold ? xold + (size_t)row * DM : (row < NCTX ? x_prompt + (size_t)row * DM : x_sample + (size_t)(row - NCTX) * DM);
#pragma unroll
      for (int n = 0; n < 2; ++n) xo1[m][n] = *(const f32x4*)(xp + col0 + n * 4);
    }
#pragma unroll
    for (int m = 0; m < 4; ++m) { pin(xo1[m][0]); pin(xo1[m][1]); }
#pragma unroll
    for (int ai = 0; ai < 2; ++ai)
#pragma unroll
      for (int m = 0; m < 4; ++m) {
        const int row = row0 + ai * 128 + m * 16;
        const f32x4 x0 = (ai ? xo1[m][0] : P.xo[m][0]) + P.gav[0] * acc[ai][0][m][0], x1 = (ai ? xo1[m][1] : P.xo[m][1]) + P.gav[1] * acc[ai][0][m][1];
        *(f32x4*)(xres + (size_t)row * DM + col0) = x0;
        *(f32x4*)(xres + (size_t)row * DM + col0 + 4) = x1;
        float sq = ((x0[0] * x0[0] + x0[1] * x0[1]) + (x0[2] * x0[2] + x0[3] * x0[3])) + ((x1[0] * x1[0] + x1[1] * x1[1]) + (x1[2] * x1[2] + x1[3] * x1[3]));
        if (Gn) {
          const f32x4 y0 = x0 * Gv[0], y1 = x1 * Gv[1];
          u32x4 w; w.x = pack2(y0[0], y0[1]); w.y = pack2(y0[2], y0[3]); w.z = pack2(y1[0], y1[1]); w.w = pack2(y1[2], y1[3]);
          *(u32x4*)(xg + (size_t)row * DM + col0) = w;
        }
        sq += __shfl_xor(sq, 16); sq += __shfl_xor(sq, 32);
        if (fq == 0) ssq[(size_t)row * 32 + u.pn * 4 + wc] = sq;
      }
  }
};
struct EpiFfi {
  bf16_t* act; unsigned tab;
  DI void operator()(const f32x4 (&acc)[2][2][4][2], const pg8::Unit& u, int wr, int wc, int fr, int fq) const {
    const int row0 = u.pm * 256 + wr * 64 + fr;
    const int acol = 128 * u.pn + 32 * wc + 8 * fq;
    const int ui = u.idx < EPI_MAXU ? u.idx : EPI_MAXU - 1;
    float rs[2][4];
    f32x4 bv[4];
    epi_read(tab + (ui * 256 + wr * 64 + fr) * 4, tab + (EPI_MAXU * 256 + ui * 256 + wc * 32 + 8 * fq) * 4, rs, bv);
#pragma unroll
    for (int ai = 0; ai < 2; ++ai)
#pragma unroll
      for (int m = 0; m < 4; ++m) {
        const int row = row0 + ai * 128 + m * 16;
        const f32x4 g0 = acc[ai][0][m][0] * rs[ai][m] + bv[0], g1 = acc[ai][0][m][1] * rs[ai][m] + bv[1];
        const f32x4 u0 = acc[ai][1][m][0] * rs[ai][m] + bv[2], u1 = acc[ai][1][m][1] * rs[ai][m] + bv[3];
        u32x4 w;
        w.x = pack2(silu_f(g0[0]) * u0[0], silu_f(g0[1]) * u0[1]);
        w.y = pack2(silu_f(g0[2]) * u0[2], silu_f(g0[3]) * u0[3]);
        w.z = pack2(silu_f(g1[0]) * u1[0], silu_f(g1[1]) * u1[1]);
        w.w = pack2(silu_f(g1[2]) * u1[2], silu_f(g1[3]) * u1[3]);
        *(u32x4*)(act + (size_t)row * DFF + acol) = w;
      }
  }
};

DI void conv_task(const Params& p, int l, int ct, char* lds) {
  const int tid = opaque_tid(), wid = tid >> 6, lane = tid & 63, fr = lane & 15, fq = lane >> 4;
  const int T0 = ct * 32;
  int ss, L, mr;
  tokinfo(T0, ss, L, mr);
  float* hs = (float*)lds;
  float* co = (float*)lds;
  char* As = lds + 32768;
  float wk[31];
#pragma unroll
  for (int k = 0; k < 31; ++k) wk[k] = p.conv_dw[(l * 31 + k) * 256 + tid];
  const float cbias = p.conv_b[l * 256 + tid];
  const f32x4 g = *(const f32x4*)(p.conv_ln_g + l * 256 + lane * 4), bb = *(const f32x4*)(p.conv_ln_b + l * 256 + lane * 4);
#pragma unroll
  for (int ib = 0; ib < 16; ib += 16) {
    f32x4 a1[16], a2[16];
#pragma unroll
    for (int q = 0; q < 16; ++q) {
      int r = (ib + q) * 4 + (tid >> 6), c4 = (tid & 63) * 4;
      int T = T0 - 15 + r;
      bool ok = r < 62 && T >= ss && T < ss + L;
      a1[q] = ok ? ld4bf(p.proj + (size_t)T * INC + c4) : f32x4{0.f, 0.f, 0.f, 0.f};
      a2[q] = ok ? ld4bf(p.proj + (size_t)T * INC + 256 + c4) : f32x4{0.f, 0.f, 0.f, 0.f};
    }
#pragma unroll
    for (int q = 0; q < 16; ++q) {
      int r = (ib + q) * 4 + (tid >> 6), c4 = (tid & 63) * 4;
      f32x4 h;
      h.x = a1[q].x * sigmoid_f(a2[q].x); h.y = a1[q].y * sigmoid_f(a2[q].y); h.z = a1[q].z * sigmoid_f(a2[q].z); h.w = a1[q].w * sigmoid_f(a2[q].w);
      if (r < 62) *(f32x4*)(hs + r * 256 + c4) = h;
    }
  }
  lds_barrier();
  float o[32];
  {
    const int c = tid;
#pragma unroll
    for (int tt = 0; tt < 32; ++tt) o[tt] = cbias;
#pragma unroll
    for (int k = 0; k < 31; ++k) {
      const float w = wk[k];
#pragma unroll
      for (int tt = 0; tt < 32; ++tt) o[tt] += w * hs[(tt + k) * 256 + c];
    }
  }
  lds_barrier();
#pragma unroll
  for (int tt = 0; tt < 32; ++tt) co[tt * 256 + tid] = o[tt];
  lds_barrier();
  const bf16_t* wt = p.wt_pw + (size_t)l * 65536;
  bf16x8 ball0[4][4];
#pragma unroll
  for (int kk = 0; kk < 4; ++kk)
#pragma unroll
    for (int n = 0; n < 4; ++n) ball0[kk][n] = *(const bf16x8*)(wt + (size_t)(wid * 64 + n * 16 + fr) * 256 + kk * 32 + fq * 8);
  {
    f32x4 v[8];
    float s[8], s2[8];
#pragma unroll
    for (int q = 0; q < 8; ++q) { v[q] = *(const f32x4*)(co + (wid * 8 + q) * 256 + lane * 4); s[q] = (v[q].x + v[q].y) + (v[q].z + v[q].w); }
#pragma unroll
    for (int of = 32; of >= 1; of >>= 1) {
      float t[8];
#pragma unroll
      for (int q = 0; q < 8; ++q) t[q] = __shfl_xor(s[q], of);
#pragma unroll
      for (int q = 0; q < 8; ++q) s[q] += t[q];
    }
#pragma unroll
    for (int q = 0; q < 8; ++q) {
      const float mu = s[q] * (1.f / 256.f);
      v[q] = v[q] - mu;
      s2[q] = (v[q].x * v[q].x + v[q].y * v[q].y) + (v[q].z * v[q].z + v[q].w * v[q].w);
    }
#pragma unroll
    for (int of = 32; of >= 1; of >>= 1) {
      float t[8];
#pragma unroll
      for (int q = 0; q < 8; ++q) t[q] = __shfl_xor(s2[q], of);
#pragma unroll
      for (int q = 0; q < 8; ++q) s2[q] += t[q];
    }
#pragma unroll
    for (int q = 0; q < 8; ++q) {
      const int tt = wid * 8 + q;
      const float rs = rsqrtf(s2[q] * (1.f / 256.f) + EPS);
      u32x2 ov;
      ov.x = pack2(silu_f(v[q].x * rs * g.x + bb.x), silu_f(v[q].y * rs * g.y + bb.y));
      ov.y = pack2(silu_f(v[q].z * rs * g.z + bb.z), silu_f(v[q].w * rs * g.w + bb.w));
      *(u32x2*)(As + tt * 528 + lane * 8) = ov;
    }
  }
  lds_barrier();
  f32x4 acc[2][4];
#pragma unroll
  for (int m = 0; m < 2; ++m)
#pragma unroll
    for (int n = 0; n < 4; ++n) acc[m][n] = f32x4{0.f, 0.f, 0.f, 0.f};
  bf16x8 ball1[4][4];
#pragma unroll
  for (int kk = 0; kk < 4; ++kk)
#pragma unroll
    for (int n = 0; n < 4; ++n) ball1[kk][n] = *(const bf16x8*)(wt + (size_t)(wid * 64 + n * 16 + fr) * 256 + (4 + kk) * 32 + fq * 8);
#pragma unroll
  for (int ks = 0; ks < 8; ++ks) {
    bf16x8 af[2];
#pragma unroll
    for (int m = 0; m < 2; ++m) af[m] = *(const bf16x8*)(As + (m * 16 + fr) * 528 + ks * 64 + fq * 16);
#pragma unroll
    for (int m = 0; m < 2; ++m)
#pragma unroll
      for (int n = 0; n < 4; ++n) acc[m][n] = MFMA16(af[m], (ks < 4 ? ball0[ks & 3][n] : ball1[ks & 3][n]), acc[m][n]);
  }
#pragma unroll
  for (int m = 0; m < 2; ++m)
#pragma unroll
    for (int j = 0; j < 4; ++j)
#pragma unroll
      for (int n = 0; n < 4; ++n)
        p.mix[(size_t)(T0 + m * 16 + fq * 4 + j) * DM + wid * 64 + n * 16 + fr] = f2bf(acc[m][n][j]);
  lds_barrier();
}

DI void pool_task(const Params& p, int l, int pt, char* lds) {
  const int tid = opaque_tid(), wid = tid >> 6, lane = tid & 63, fr = lane & 15, fq = lane >> 4;
  const int T0 = pt * 32;
  int ss, L, mr;
  tokinfo(T0, ss, L, mr);
  float* ps = (float*)lds;
  const bf16_t* wt = p.wt_pool + (size_t)(l * 4 + wid) * 4096;
  bf16x8 pwf[2][4];
#pragma unroll
  for (int ks = 0; ks < 2; ++ks)
#pragma unroll
    for (int n = 0; n < 4; ++n) pwf[ks][n] = *(const bf16x8*)(wt + (n * 16 + fr) * 64 + ks * 32 + fq * 8);
  float scv[4];
#pragma unroll
  for (int n = 0; n < 4; ++n) scv[n] = p.pool_scale[l * 256 + wid * 64 + n * 16 + fr];
  char* As = lds + 49152;
#pragma unroll
  for (int ib = 0; ib < 12; ib += 12) {
    f32x4 v[12];
#pragma unroll
    for (int q = 0; q < 12; ++q) {
      int r = (ib + q) * 4 + (tid >> 6), c4 = (tid & 63) * 4;
      int T = T0 - 8 + r;
      bool ok = T >= ss && T < ss + L;
      v[q] = ok ? ld4bf(p.proj + (size_t)T * INC + 1024 + c4) : f32x4{0.f, 0.f, 0.f, 0.f};
    }
#pragma unroll
    for (int q = 0; q < 12; ++q) {
      int r = (ib + q) * 4 + (tid >> 6), c4 = (tid & 63) * 4;
      *(f32x4*)(ps + r * 256 + c4) = v[q];
    }
  }
  lds_barrier();
  {
    const int c = tid, gi = wid, hw = 1 << gi;
    const int tl0 = T0 - ss;
    float s = 0.f;
    for (int r = 8 - hw; r < 8 + hw; ++r) s += ps[r * 256 + c];
#pragma unroll 8
    for (int tt = 0; tt < 32; ++tt) {
      int t = tl0 + tt;
      int lo = max(t - hw, 0), hi = min(t + hw, L);
      float d = s / (float)(hi - lo) - ps[(tt + 8) * 256 + c];
      *(bf16_t*)(As + tt * 528 + c * 2) = f2bf(d);
      s += ps[(tt + 8 + hw) * 256 + c] - ps[(tt + 8 - hw) * 256 + c];
    }
  }
  lds_barrier();
  f32x4 acc[2][4];
#pragma unroll
  for (int m = 0; m < 2; ++m)
#pragma unroll
    for (int n = 0; n < 4; ++n) acc[m][n] = f32x4{0.f, 0.f, 0.f, 0.f};
#pragma unroll
  for (int ks = 0; ks < 2; ++ks) {
    bf16x8 af[2];
#pragma unroll
    for (int m = 0; m < 2; ++m) af[m] = *(const bf16x8*)(As + (m * 16 + fr) * 528 + (wid * 64 + ks * 32 + fq * 8) * 2);
#pragma unroll
    for (int m = 0; m < 2; ++m)
#pragma unroll
      for (int n = 0; n < 4; ++n) acc[m][n] = MFMA16(af[m], pwf[ks][n], acc[m][n]);
  }
#pragma unroll
  for (int n = 0; n < 4; ++n) {
    int col = wid * 64 + n * 16 + fr;
    float sc = scv[n];
#pragma unroll
    for (int m = 0; m < 2; ++m)
#pragma unroll
      for (int j = 0; j < 4; ++j)
        p.mix[(size_t)(T0 + m * 16 + fq * 4 + j) * DM + 512 + col] = f2bf(acc[m][n][j] * sc);
  }
  lds_barrier();
}

DI void stage_vT(const bf16_t* src  , char* vT) {
  const int tid = opaque_tid();
  u32x2 vv[8];
#pragma unroll
  for (int i = 0; i < 8; ++i) { int idx = tid + 256 * i; vv[i] = *(const u32x2*)(src + (size_t)(idx >> 4) * INC + (idx & 15) * 4); }
#pragma unroll
  for (int i = 0; i < 8; ++i) {
    int idx = tid + 256 * i, q = idx >> 4, d4 = (idx & 15) * 4;
    const u32x2 v = vv[i];
    *(bf16_t*)(vT + (d4 + 0) * 272 + q * 2) = (bf16_t)(v.x & 0xffffu);
    *(bf16_t*)(vT + (d4 + 1) * 272 + q * 2) = (bf16_t)(v.x >> 16);
    *(bf16_t*)(vT + (d4 + 2) * 272 + q * 2) = (bf16_t)(v.y & 0xffffu);
    *(bf16_t*)(vT + (d4 + 3) * 272 + q * 2) = (bf16_t)(v.y >> 16);
  }
}

DI void gmlp_task(const Params& p, int l, int cgi, int h, char* lds) {
  const int tid = opaque_tid(), wid = tid >> 6, lane = tid & 63, fr = lane & 15, fq = lane >> 4;
  const int T0 = cgi * 128;
  char* vT = lds;
  const float* wsb = p.gmlp_ws + (size_t)(l * 4 + h) * 16384;
  f32x4 araw[4][2][2];
#pragma unroll
  for (int ks = 0; ks < 4; ++ks)
#pragma unroll
    for (int m = 0; m < 2; ++m) {
      const float* ap = wsb + (wid * 32 + m * 16 + fr) * 128 + ks * 32 + fq * 8;
      araw[ks][m][0] = *(const f32x4*)ap; araw[ks][m][1] = *(const f32x4*)(ap + 4);
    }
  bf16_t uraw[2][4][4];
  float braw[2][4];
#pragma unroll
  for (int m = 0; m < 2; ++m)
#pragma unroll
    for (int j = 0; j < 4; ++j) {
      int pp = wid * 32 + m * 16 + fq * 4 + j;
      braw[m][j] = p.gmlp_b[(l * 4 + h) * 128 + pp];
#pragma unroll
      for (int n = 0; n < 4; ++n) uraw[m][j][n] = p.proj[(size_t)(T0 + pp) * INC + 512 + h * 64 + n * 16 + fr];
    }
  stage_vT(p.proj + (size_t)T0 * INC + 768 + h * 64, vT);
  lds_barrier();
  f32x4 acc[2][4];
#pragma unroll
  for (int m = 0; m < 2; ++m)
#pragma unroll
    for (int n = 0; n < 4; ++n) acc[m][n] = f32x4{0.f, 0.f, 0.f, 0.f};
#pragma unroll
  for (int ks = 0; ks < 4; ++ks) {
    bf16x8 af[2], bfr[4];
#pragma unroll
    for (int m = 0; m < 2; ++m) {
      const f32x4 a = araw[ks][m][0], b = araw[ks][m][1];
      u32x4 u;
      u.x = pack2(a.x, a.y); u.y = pack2(a.z, a.w); u.z = pack2(b.x, b.y); u.w = pack2(b.z, b.w);
      af[m] = __builtin_bit_cast(bf16x8, u);
    }
#pragma unroll
    for (int n = 0; n < 4; ++n) bfr[n] = *(const bf16x8*)(vT + (n * 16 + fr) * 272 + ks * 64 + fq * 16);
#pragma unroll
    for (int m = 0; m < 2; ++m)
#pragma unroll
      for (int n = 0; n < 4; ++n) acc[m][n] = MFMA16(af[m], bfr[n], acc[m][n]);
  }
#pragma unroll
  for (int m = 0; m < 2; ++m)
#pragma unroll
    for (int j = 0; j < 4; ++j) {
      int pp = wid * 32 + m * 16 + fq * 4 + j;
#pragma unroll
      for (int n = 0; n < 4; ++n) {
        int d = n * 16 + fr;
        p.mix[(size_t)(T0 + pp) * DM + 256 + h * 64 + d] = f2bf(bf2f(uraw[m][j][n]) * (acc[m][n][j] + braw[m][j]));
      }
    }
  lds_barrier();
}

DI void rope_load(const Params& p, const bf16_t* src  , bool rot, int pos, int i4, f32x4& o1, f32x4& o2) {
  f32x4 x1 = ld4bf(src), x2 = ld4bf(src + 16);
  if (rot) {
    const f32x4* cs = (const f32x4*)(p.rope + (pos * 16 + 4 * i4) * 2);
    f32x4 c01 = cs[0], c23 = cs[1];
    o1.x = x1.x * c01.x - x2.x * c01.y; o2.x = x1.x * c01.y + x2.x * c01.x;
    o1.y = x1.y * c01.z - x2.y * c01.w; o2.y = x1.y * c01.w + x2.y * c01.z;
    o1.z = x1.z * c23.x - x2.z * c23.y; o2.z = x1.z * c23.y + x2.z * c23.x;
    o1.w = x1.w * c23.z - x2.w * c23.w; o2.w = x1.w * c23.w + x2.w * c23.z;
  } else { o1 = x1; o2 = x2; }
}

DI void kv_task(const Params& p, int l, int cgi, int h, int dir, char* lds) {
  const int tid = opaque_tid(), wid = tid >> 6, lane = tid & 63, fr = lane & 15, fq = lane >> 4;
  const int T0 = cgi * 128;
  int ss, L, mr;
  tokinfo(T0, ss, L, mr);
  const bool rot = mr > 0;
  const float lg = loggamma(p, l, dir, h);
  char* kT = lds;
  char* vT = lds + 17408;
  stage_vT(p.proj + (size_t)T0 * INC + 2304 + h * 64, vT);
  const int kcol = 1280 + (dir ? 768 : 256) + h * 64;
  f32x4 ko1[4], ko2[4];
#pragma unroll
  for (int it = 0; it < 4; ++it) {
    int idx = tid + 256 * it, j = idx >> 3, hf = (idx >> 2) & 1, i4 = idx & 3;
    int tl = T0 - ss + j;
    int pos = hf ? (tl & 63) : (tl >> 6);
    rope_load(p, p.proj + (size_t)(T0 + j) * INC + kcol + 32 * hf + 4 * i4, rot, pos, i4, ko1[it], ko2[it]);
  }
#pragma unroll
  for (int it = 0; it < 4; ++it) {
    int idx = tid + 256 * it, j = idx >> 3, hf = (idx >> 2) & 1, i4 = idx & 3;
    const f32x4 o1 = ko1[it], o2 = ko2[it];
    float wj = __expf(lg * (float)(dir ? j : 127 - j)) * 0.125f;
    int d1 = 32 * hf + 4 * i4, d2 = d1 + 16;
    *(bf16_t*)(kT + (d1 + 0) * 272 + j * 2) = f2bf(o1.x * wj);
    *(bf16_t*)(kT + (d1 + 1) * 272 + j * 2) = f2bf(o1.y * wj);
    *(bf16_t*)(kT + (d1 + 2) * 272 + j * 2) = f2bf(o1.z * wj);
    *(bf16_t*)(kT + (d1 + 3) * 272 + j * 2) = f2bf(o1.w * wj);
    *(bf16_t*)(kT + (d2 + 0) * 272 + j * 2) = f2bf(o2.x * wj);
    *(bf16_t*)(kT + (d2 + 1) * 272 + j * 2) = f2bf(o2.y * wj);
    *(bf16_t*)(kT + (d2 + 2) * 272 + j * 2) = f2bf(o2.z * wj);
    *(bf16_t*)(kT + (d2 + 3) * 272 + j * 2) = f2bf(o2.w * wj);
  }
  lds_barrier();
  f32x4 acc[4];
#pragma unroll
  for (int n = 0; n < 4; ++n) acc[n] = f32x4{0.f, 0.f, 0.f, 0.f};
#pragma unroll
  for (int ks = 0; ks < 4; ++ks) {
    bf16x8 af = *(const bf16x8*)(kT + (wid * 16 + fr) * 272 + ks * 64 + fq * 16);
#pragma unroll
    for (int n = 0; n < 4; ++n) {
      bf16x8 bfr = *(const bf16x8*)(vT + (n * 16 + fr) * 272 + ks * 64 + fq * 16);
      acc[n] = MFMA16(af, bfr, acc[n]);
    }
  }
  float* kv = p.KV + (size_t)((cgi * 4 + h) * 2 + dir) * 4096;
#pragma unroll
  for (int n = 0; n < 4; ++n)
#pragma unroll
    for (int j = 0; j < 4; ++j) kv[(wid * 16 + fq * 4 + j) * 64 + n * 16 + fr] = acc[n][j];
  lds_barrier();
}

DI void ret_task(const Params& p, int l, int cgi, int h, int dir, char* lds, char* lds_partner) {
  const int tid = opaque_tid(), wid = __builtin_amdgcn_readfirstlane(tid >> 6), lane = tid & 63, fr = lane & 15, fq = lane >> 4;
  const int T0 = cgi * 128;
  int ss, L, mr;
  tokinfo(T0, ss, L, mr);
  const bool rot = mr > 0;
  const int nc = L >> 7, c = (T0 - ss) >> 7, cg0 = ss >> 7;
  const int i0 = wid * 32;
  char* Qs = lds;
  char* Ks = lds + 18432;
  char* vT = lds + 36864;
  char* ST = lds + 54272;
  char* att = lds + 63488 + wid * 2560;
  f32x4 o[2][4];
#pragma unroll
  for (int m = 0; m < 2; ++m)
#pragma unroll
    for (int n = 0; n < 4; ++n) o[m][n] = f32x4{0.f, 0.f, 0.f, 0.f};
  stage_vT(p.proj + (size_t)T0 * INC + 2304 + h * 64, vT);
  const float lg = loggamma(p, l, dir, h);
  {
    float s[16];
    const float* s0 = rot ? p.state_ret + (size_t)((((mr - 1) * 2 + l) * 2 + dir) * 4 + h) * 4096 : nullptr;
    const float f0 = __expf(lg * 128.f * (float)(dir ? nc - 1 - c : c));
#pragma unroll
    for (int i = 0; i < 16; ++i) s[i] = s0 ? s0[tid + 256 * i] * f0 : 0.f;
    const int mlo = dir ? c + 1 : 0, mhi = dir ? nc : c;
#pragma unroll 1
    for (int mb = mlo; mb < mhi; mb += 4) {
      float kvv[4][16], f[4];
#pragma unroll
      for (int q = 0; q < 4; ++q) {
        const int m = min(mb + q, mhi - 1);
        f[q] = (mb + q < mhi) ? __expf(lg * 128.f * (float)(dir ? m - c - 1 : c - 1 - m)) : 0.f;
        const float* kv = p.KV + (size_t)(((cg0 + m) * 4 + h) * 2 + dir) * 4096 + tid;
#pragma unroll
        for (int i = 0; i < 16; ++i) kvv[q][i] = kv[256 * i];
      }
#pragma unroll
      for (int q = 0; q < 4; ++q)
#pragma unroll
        for (int i = 0; i < 16; ++i) s[i] += kvv[q][i] * f[q];
    }
#pragma unroll
    for (int i = 0; i < 16; ++i) {
      int el = tid + 256 * i, d = el >> 6, e = el & 63;
      *(bf16_t*)(ST + e * 144 + d * 2) = f2bf(s[i]);
    }
    if (!rot && c == 0) {
#pragma unroll
      for (int i = 0; i < 16; ++i) s[i] = 0.f;
#pragma unroll 1
      for (int m = 0; m < nc; ++m) {
        const float f = __expf(lg * 128.f * (float)(dir ? m : nc - 1 - m));
        const float* kv = p.KV + (size_t)(((cg0 + m) * 4 + h) * 2 + dir) * 4096 + tid;
#pragma unroll
        for (int i = 0; i < 16; ++i) s[i] += kv[256 * i] * f;
      }
      const int b = ss >> 8;
      float* op = p.out + (size_t)NTOK * DM + (size_t)((((b * 2 + l) * 2 + dir) * 4 + h)) * 4096 + tid;
#pragma unroll
      for (int i = 0; i < 16; ++i) op[256 * i] = s[i];
    }
  }
  {
    const int qcol = 1280 + (dir ? 512 : 0) + h * 64, kcol = qcol + 256;
    f32x4 q1[4], q2[4], k1[4], k2[4];
#pragma unroll
    for (int it = 0; it < 4; ++it) {
      int idx = tid + 256 * it, j = idx >> 3, hf = (idx >> 2) & 1, i4 = idx & 3;
      int tl = T0 - ss + j;
      int pos = hf ? (tl & 63) : (tl >> 6);
      const bf16_t* rowp = p.proj + (size_t)(T0 + j) * INC + 32 * hf + 4 * i4;
      rope_load(p, rowp + qcol, rot, pos, i4, q1[it], q2[it]);
      rope_load(p, rowp + kcol, rot, pos, i4, k1[it], k2[it]);
    }
#pragma unroll
    for (int it = 0; it < 4; ++it) {
      int idx = tid + 256 * it, j = idx >> 3, hf = (idx >> 2) & 1, i4 = idx & 3;
      f32x4 o1 = q1[it], o2 = q2[it];
      u32x2 u1, u2;
      u1.x = pack2(o1.x, o1.y); u1.y = pack2(o1.z, o1.w); u2.x = pack2(o2.x, o2.y); u2.y = pack2(o2.z, o2.w);
      *(u32x2*)(Qs + j * 144 + (32 * hf + 4 * i4) * 2) = u1;
      *(u32x2*)(Qs + j * 144 + (32 * hf + 16 + 4 * i4) * 2) = u2;
      o1 = k1[it]; o2 = k2[it];
      u1.x = pack2(o1.x * 0.125f, o1.y * 0.125f); u1.y = pack2(o1.z * 0.125f, o1.w * 0.125f);
      u2.x = pack2(o2.x * 0.125f, o2.y * 0.125f); u2.y = pack2(o2.z * 0.125f, o2.w * 0.125f);
      *(u32x2*)(Ks + j * 144 + (32 * hf + 4 * i4) * 2) = u1;
      *(u32x2*)(Ks + j * 144 + (32 * hf + 16 + 4 * i4) * 2) = u2;
    }
  }
  lds_barrier();
  bf16_t graw[2][4][4];
#pragma unroll
  for (int m = 0; m < 2; ++m)
#pragma unroll
    for (int j = 0; j < 4; ++j) {
      const bf16_t* gp = p.proj + (size_t)(T0 + i0 + m * 16 + fq * 4 + j) * INC + 2560 + h * 64 + fr;
#pragma unroll
      for (int n = 0; n < 4; ++n) graw[m][j][n] = gp[16 * n];
    }
  bf16x8 qf[2][2];
#pragma unroll
  for (int m = 0; m < 2; ++m)
#pragma unroll
    for (int ks = 0; ks < 2; ++ks) qf[m][ks] = *(const bf16x8*)(Qs + (i0 + m * 16 + fr) * 144 + ks * 64 + fq * 16);
  {
#pragma unroll
    for (int ks = 0; ks < 2; ++ks)
#pragma unroll
      for (int n = 0; n < 4; ++n) {
        bf16x8 bfr = *(const bf16x8*)(ST + (n * 16 + fr) * 144 + ks * 64 + fq * 16);
#pragma unroll
        for (int m = 0; m < 2; ++m) o[m][n] = MFMA16(qf[m][ks], bfr, o[m][n]);
      }
#pragma unroll
    for (int m = 0; m < 2; ++m)
#pragma unroll
      for (int j = 0; j < 4; ++j) {
        int i = i0 + m * 16 + fq * 4 + j;
        float rsf = __expf(lg * (float)(dir ? 128 - i : i + 1));
#pragma unroll
        for (int n = 0; n < 4; ++n) o[m][n][j] *= rsf;
      }
  }
  const int jlo = dir ? wid : 0, jhi = dir ? 3 : wid;
#pragma unroll 1
  for (int jb = jlo; jb <= jhi; ++jb) {
    f32x4 s[2][2];
#pragma unroll
    for (int m = 0; m < 2; ++m)
#pragma unroll
      for (int n = 0; n < 2; ++n) s[m][n] = f32x4{0.f, 0.f, 0.f, 0.f};
#pragma unroll
    for (int ks = 0; ks < 2; ++ks)
#pragma unroll
      for (int n = 0; n < 2; ++n) {
        bf16x8 bfr = *(const bf16x8*)(Ks + (jb * 32 + n * 16 + fr) * 144 + ks * 64 + fq * 16);
#pragma unroll
        for (int m = 0; m < 2; ++m) s[m][n] = MFMA16(qf[m][ks], bfr, s[m][n]);
      }
#pragma unroll
    for (int m = 0; m < 2; ++m)
#pragma unroll
      for (int n = 0; n < 2; ++n)
#pragma unroll
        for (int j = 0; j < 4; ++j) {
          int i = i0 + m * 16 + fq * 4 + j, jj = jb * 32 + n * 16 + fr;
          int df = dir ? jj - i : i - jj;
          float dec = df >= 0 ? __expf(lg * (float)df) : 0.f;
          *(bf16_t*)(att + (m * 16 + fq * 4 + j) * 80 + (n * 16 + fr) * 2) = f2bf(s[m][n][j] * dec);
        }
    asm volatile("s_waitcnt lgkmcnt(0)" ::: "memory");
    bf16x8 af[2];
#pragma unroll
    for (int m = 0; m < 2; ++m) af[m] = *(const bf16x8*)(att + (m * 16 + fr) * 80 + fq * 16);
#pragma unroll
    for (int n = 0; n < 4; ++n) {
      bf16x8 bfr = *(const bf16x8*)(vT + (n * 16 + fr) * 272 + (jb * 32 + fq * 8) * 2);
#pragma unroll
      for (int m = 0; m < 2; ++m) o[m][n] = MFMA16(af[m], bfr, o[m][n]);
    }
    asm volatile("s_waitcnt lgkmcnt(0)" ::: "memory");
  }
  lds_barrier();
  const bool mine = (wid >> 1) == dir;
  if (!mine) {
    float* ex = (float*)lds_partner + ((wid & 1) * 32) * 64 + lane;
#pragma unroll
    for (int m = 0; m < 2; ++m)
#pragma unroll
      for (int n = 0; n < 4; ++n)
#pragma unroll
        for (int j = 0; j < 4; ++j) ex[(m * 16 + n * 4 + j) * 64] = o[m][n][j];
  }
  lds_barrier();
  if (mine) {
    const float* ex = (const float*)lds + ((wid & 1) * 32) * 64 + lane;
#pragma unroll
    for (int m = 0; m < 2; ++m)
#pragma unroll
      for (int n = 0; n < 4; ++n)
#pragma unroll
        for (int j = 0; j < 4; ++j) o[m][n][j] += ex[(m * 16 + n * 4 + j) * 64];
    float gs[2][4], gq[2][4];
#pragma unroll
    for (int m = 0; m < 2; ++m)
#pragma unroll
      for (int j = 0; j < 4; ++j) gs[m][j] = (o[m][0][j] + o[m][1][j]) + (o[m][2][j] + o[m][3][j]);
#pragma unroll
    for (int of = 1; of <= 8; of <<= 1) {
      float t[2][4];
#pragma unroll
      for (int m = 0; m < 2; ++m)
#pragma unroll
        for (int j = 0; j < 4; ++j) t[m][j] = __shfl_xor(gs[m][j], of);
#pragma unroll
      for (int m = 0; m < 2; ++m)
#pragma unroll
        for (int j = 0; j < 4; ++j) gs[m][j] += t[m][j];
    }
#pragma unroll
    for (int m = 0; m < 2; ++m)
#pragma unroll
      for (int j = 0; j < 4; ++j) {
        const float mu = gs[m][j] * (1.f / 64.f);
#pragma unroll
        for (int n = 0; n < 4; ++n) o[m][n][j] -= mu;
        gq[m][j] = (o[m][0][j] * o[m][0][j] + o[m][1][j] * o[m][1][j]) + (o[m][2][j] * o[m][2][j] + o[m][3][j] * o[m][3][j]);
      }
#pragma unroll
    for (int of = 1; of <= 8; of <<= 1) {
      float t[2][4];
#pragma unroll
      for (int m = 0; m < 2; ++m)
#pragma unroll
        for (int j = 0; j < 4; ++j) t[m][j] = __shfl_xor(gq[m][j], of);
#pragma unroll
      for (int m = 0; m < 2; ++m)
#pragma unroll
        for (int j = 0; j < 4; ++j) gq[m][j] += t[m][j];
    }
#pragma unroll
    for (int m = 0; m < 2; ++m)
#pragma unroll
      for (int j = 0; j < 4; ++j) {
        const float rs = rsqrtf(gq[m][j] * (1.f / 64.f) + EPS);
        const int T = T0 + i0 + m * 16 + fq * 4 + j;
        bf16_t* mp = p.mix + (size_t)T * DM + 768 + h * 64 + fr;
        mp[0] = f2bf(silu_f(bf2f(graw[m][j][0])) * o[m][0][j] * rs);
        mp[16] = f2bf(silu_f(bf2f(graw[m][j][1])) * o[m][1][j] * rs);
        mp[32] = f2bf(silu_f(bf2f(graw[m][j][2])) * o[m][2][j] * rs);
        mp[48] = f2bf(silu_f(bf2f(graw[m][j][3])) * o[m][3][j] * rs);
      }
  }
  lds_barrier();
}

DI void phase_final(const Params& p, int vbi, int nvb) {
  const int tid = opaque_tid(), wid = tid >> 6, lane = tid & 63;
  for (int t = vbi; t < NTOK / 4; t += nvb) {
    int T = t * 4 + wid;
    f32x4 xv[4], gv[4];
#pragma unroll
    for (int i = 0; i < 4; ++i) { int k = i * 256 + lane * 4; xv[i] = *(const f32x4*)(p.xres + (size_t)T * DM + k); gv[i] = *(const f32x4*)(p.g_final + k); }
    float rs = row_rstd(p.ssq, T);
#pragma unroll
    for (int i = 0; i < 4; ++i) { pin(xv[i]); pin(gv[i]); }
#pragma unroll
    for (int i = 0; i < 4; ++i) {
      int k = i * 256 + lane * 4;
      f32x4 v = xv[i];
      f32x4 g = gv[i];
      f32x4 y = f32x4{v.x * rs * g.x, v.y * rs * g.y, v.z * rs * g.z, v.w * rs * g.w};
      *(f32x4*)(p.out + (size_t)T * DM + k) = y;
    }
  }
}

__global__ void __launch_bounds__(512, 2) mega(Params p, int ph_lo, int ph_hi) {
  __shared__ __attribute__((aligned(16))) char lds_all[2 * 73728];
  __shared__ u32x4 xb_words;
  cg::grid_group grid = cg::this_grid();
  if (threadIdx.x == 0) xb_words = u32x4{0u, 0u, 0u, 0u};
  __syncthreads();
  XcdBarrier xb = xcd_barrier_post(p.bar, (volatile LAS unsigned*)&xb_words);
  if (ph_hi > NPH) grid.sync();
  LAS unsigned char* glds = (LAS unsigned char*)lds_all;
  for (int ph = ph_lo; ph < ph_hi; ++ph) {
    if (ph > ph_lo) xcd_barrier(xb);
    int bid = blockIdx.x, vb = (int)(threadIdx.x >> 8);
    asm volatile("" : "+s"(bid));
    asm volatile("" : "+v"(vb));
    vb = __builtin_amdgcn_readfirstlane(vb);
    char* lds = lds_all + vb * 73728;
    const int vbi = bid * 2 + vb, nvb = gridDim.x * 2;
    if (ph == 0) phase_prep0(p, lds, vbi, nvb);
    else if (ph == 1) phase_prep1(p, lds, vbi, nvb);
    else if (ph == NPH - 1) phase_final(p, vbi, nvb);
    else {
      const int l = (ph - 2) / 6, sub = (ph - 2) % 6;
      pg8::StaticOrder S;
      if (sub == 0) {
        pg8::Gemm g{p.xg, p.wt_in + (size_t)l * INC * 1024, NTOK, INC, 1024};
        S.init(NTOK, INC, 256, gridDim.x, bid, 4);
        epi_tables(lds_all + 131072, S, p.ssq, p.biasIn + (size_t)l * 5 * INC, false);
        EpiIn E{p.proj, (unsigned)(size_t)(glds + 131072)};
        pg8::gemm_phase<2>(glds, g, S, E);
        const int lo_in = gridDim.x == 256 ? 96 : 0;
        if (bid >= lo_in) {
          DecRest dec{&p, l};
          transpose_run((bid - lo_in) * 2 + vb, 2368, (gridDim.x - lo_in) * 2, dec, lds);
        }
      } else if (sub == 1) {
        for (int b = bid; b < 256; b += gridDim.x) {
          const int g = b >> 1;
          if ((b & 1) == 0) {
            conv_task(p, l, 2 * g + vb, lds);
            { int u = 2 * g + vb; kv_task(p, l, u >> 3, (u >> 1) & 3, u & 1, lds); }
          } else {
            { int u = 2 * g + vb; gmlp_task(p, l, u >> 2, u & 3, lds); }
            pool_task(p, l, 2 * g + vb, lds);
            { int u = 256 + 2 * g + vb; kv_task(p, l, u >> 3, (u >> 1) & 3, u & 1, lds); }
          }
        }
      } else if (sub == 2) {
        for (int t = vbi; t < 176; t += nvb) bias_task(p, l, 1, t);
        for (int b = bid; b < 256; b += gridDim.x) ret_task(p, l, b >> 2, b & 3, vb, lds, lds_all + (1 - vb) * 73728);
      } else if (sub == 3) {
        pg8::Gemm g{p.mix, p.wt_out + (size_t)l * 1024 * 1024, NTOK, 1024, 1024};
        S.init(NTOK, 1024, 128, gridDim.x, bid, 4);
        EpiRes E{l == 0 ? nullptr : p.xres, p.x_prompt, p.x_sample, p.xres, p.xg, p.ssq, p.mod + (size_t)l * 5 * 6144 + 2048, p.G2 + l * 5 * 1024};
        pg8::gemm_phase_n128<ResPre>(glds, g, S, E);
      } else if (sub == 4) {
        pg8::Gemm g{p.xg, p.wt_ffi + (size_t)l * 5632 * 1024, NTOK, 5632, 1024};
        S.init(NTOK, 5632, 256, gridDim.x, bid, 4);
        epi_tables(lds_all + 131072, S, p.ssq, p.biasFf + (size_t)l * 5 * 5632, true);
        EpiFfi E{p.act, (unsigned)(size_t)(glds + 131072)};
        pg8::gemm_phase<2>(glds, g, S, E);
        const int lo_ff = gridDim.x == 256 ? 192 : 0;
        if (l == 0 && bid >= lo_ff) {
          DecIn1 dec{&p};
          transpose_run((bid - lo_ff) * 2 + vb, 704, (gridDim.x - lo_ff) * 2, dec, lds);
        }
      } else {
        if (l == 0) for (int t = vbi; t < 88; t += nvb) bias_task(p, 1, 0, t);
        pg8::Gemm g{p.act, p.wt_ffo + (size_t)l * 1024 * DFF, NTOK, 1024, DFF};
        S.init(NTOK, 1024, 128, gridDim.x, bid, 4);
        EpiRes E{p.xres, p.x_prompt, p.x_sample, p.xres, p.xg, p.ssq, p.mod + (size_t)l * 5 * 6144 + 5120, l == 0 ? p.G1 + 5 * 1024 : nullptr};
        pg8::gemm_phase_n128<ResPre>(glds, g, S, E);
      }
    }
  }
}

extern "C" void kernel_launch(void* const* d_in, const int* in_sizes, int n_in, void* d_out, int out_size, void* d_ws,
                              size_t ws_size, hipStream_t stream) {
  static int grid_blocks = 0;
  if (!grid_blocks) {
    int dev = 0, cus = 0, per_cu = 0;
    hipGetDevice(&dev);
    hipDeviceGetAttribute(&cus, hipDeviceAttributeMultiprocessorCount, dev);
    hipOccupancyMaxActiveBlocksPerMultiprocessor(&per_cu, mega, 512, 0);
    if (per_cu > 1) per_cu = 1;
    if (per_cu < 1) per_cu = 1;
    grid_blocks = cus * per_cu;
  }
  Params p{};
  const float** ip = (const float**)&p;
  for (int i = 0; i < 24; ++i) ip[i] = (const float*)d_in[i];
  p.out = (float*)d_out;
  char* w = (char*)d_ws;
  size_t off = 0;
  auto take = [&](size_t bytes) { char* r = w + off; off += (bytes + 255) & ~(size_t)255; return r; };
  p.wt_in = (bf16_t*)take((size_t)2 * INC * 1024 * 2);
  p.wt_out = (bf16_t*)take((size_t)2 * 1024 * 1024 * 2);
  p.wt_ffi = (bf16_t*)take((size_t)2 * 5632 * 1024 * 2);
  p.wt_ffo = (bf16_t*)take((size_t)2 * 1024 * DFF * 2);
  p.wt_pw = (bf16_t*)take((size_t)2 * 65536 * 2);
  p.wt_pool = (bf16_t*)take((size_t)2 * 4 * 4096 * 2);
  p.mod = (float*)take((size_t)2 * 5 * 6144 * 4);
  p.G1 = (float*)take((size_t)2 * 5 * 1024 * 4);
  p.G2 = (float*)take((size_t)2 * 5 * 1024 * 4);
  p.biasIn = (float*)take((size_t)2 * 5 * INC * 4);
  p.biasFf = (float*)take((size_t)2 * 5 * 5632 * 4);
  p.rope = (float*)take((size_t)64 * 16 * 2 * 4);
  p.xg = (bf16_t*)take((size_t)NTOK * DM * 2);
  p.ssq = (float*)take((size_t)NTOK * 32 * 4);
  p.xres = (float*)take((size_t)NTOK * DM * 4);
  p.proj = (bf16_t*)take((size_t)NTOK * INC * 2);
  p.act = p.proj;
  p.mix = (bf16_t*)take((size_t)NTOK * DM * 2);
  p.KV = (float*)take((size_t)512 * 4096 * 4);
  p.bar = (unsigned*)take((size_t)XCD_BAR_WORDS * 4);
  hipMemsetAsync(p.bar, 0, (size_t)XCD_BAR_WORDS * 4, stream);
#if SINGLE_LAUNCH
  int lo = 0, hi = NPH;
  void* args[] = {&p, &lo, &hi};
  hipError_t e = hipLaunchCooperativeKernel((void*)mega, dim3(grid_blocks), dim3(512), args, 0, stream);
  if (e != hipSuccess) fprintf(stderr, "cooperative launch failed: %s (grid %d)\n", hipGetErrorString(e), grid_blocks);
#else
  for (int ph = 0; ph < NPH; ++ph) {
    int lo = ph, hi = ph + 1;
    void* args[] = {&p, &lo, &hi};
    hipError_t e = hipLaunchCooperativeKernel((void*)mega, dim3(grid_blocks), dim3(512), args, 0, stream);
    if (e != hipSuccess) fprintf(stderr, "cooperative launch failed: %s (grid %d)\n", hipGetErrorString(e), grid_blocks);
  }
#endif
}
```
